# Optimizing an MI355X kernel written in HIP

```python
import jax, jax.numpy as jnp
from jax import lax
import numpy as np

D_MODEL = 1024
BATCH = 8
SEQ = 2048
DEPTH = 1

D_MIX = D_MODEL
RET_WIDTH = D_MIX // 2
POOL_WIDTH = D_MIX - RET_WIDTH
RET_HEADS = 4
RET_HEAD_DIM = RET_WIDTH // RET_HEADS
RET_CHUNK = 128
ROPE_BASE = 10000.0
POOL_WINDOWS = (2, 4, 8, 16)
POOL_GROUPS = len(POOL_WINDOWS)
POOL_GROUP_DIM = POOL_WIDTH // POOL_GROUPS
IN_COLS = 4 * RET_WIDTH + POOL_WIDTH
N_GROUPS = 4
EXPERTS_PER_GROUP = 8
N_EXPERTS = N_GROUPS * EXPERTS_PER_GROUP
TOP_K_INNER = 2
D_EXPERT = 256
ALPHA = (2.0 * DEPTH) ** 0.25
BETA = (8.0 * DEPTH) ** -0.25
LN_EPS = 1e-5

kernel_name = "hymba_retention_pool_hiermoe_deepnorm_adaln"


def _layer_norm(x, w=None, b=None):
    xf = x.astype(jnp.float32)
    mu = jnp.mean(xf, axis=-1, keepdims=True)
    var = jnp.mean(jnp.square(xf - mu), axis=-1, keepdims=True)
    y = (xf - mu) * lax.rsqrt(var + LN_EPS)
    if w is not None:
        y = y * w.astype(jnp.float32) + b.astype(jnp.float32)
    return y.astype(x.dtype)


def _rotary(t, cos, sin):
    t1, t2 = jnp.split(t, 2, axis=-1)
    return jnp.concatenate([t1 * cos - t2 * sin, t1 * sin + t2 * cos], axis=-1)


def _retention(q, k, v):
    B, S, H, Dh = q.shape
    nc = S // RET_CHUNK
    lg = jnp.log1p(-jnp.exp2(-5.0 - jnp.arange(H, dtype=jnp.float32)))
    qc = q.reshape(B, nc, RET_CHUNK, H, Dh)
    kc = k.reshape(B, nc, RET_CHUNK, H, Dh)
    vc = v.reshape(B, nc, RET_CHUNK, H, Dh)
    i = jnp.arange(RET_CHUNK, dtype=jnp.float32)
    rel = i[:, None] - i[None, :]
    dmat = jnp.where(rel[None] >= 0, jnp.exp(jnp.maximum(rel, 0.0)[None] * lg[:, None, None]), 0.0)
    scores = jnp.einsum('bnchd,bnmhd->bnhcm', qc, kc) * dmat[None, None]
    intra = jnp.einsum('bnhcm,bnmhd->bnchd', scores, vc)
    k_decay = jnp.exp((RET_CHUNK - 1.0 - i)[None, :] * lg[:, None])
    kv = jnp.einsum('bnmhd,hm,bnmhe->nbhde', kc, k_decay, vc)
    chunk_decay = jnp.exp(RET_CHUNK * lg)[None, :, None, None]

    def step(state, kv_n):
        return state * chunk_decay + kv_n, state

    _, prev = lax.scan(step, jnp.zeros((B, H, Dh, Dh), jnp.float32), kv)
    q_decay = jnp.exp((i + 1.0)[:, None] * lg[None, :])
    cross = jnp.einsum('bnchd,nbhde,ch->bnche', qc, prev, q_decay)
    return (intra + cross).reshape(B, S, H, Dh)


def _multi_scale_pool(p):
    B, S, _ = p.shape
    pf = p.astype(jnp.float32)
    cs = jnp.concatenate([jnp.zeros((B, 1, POOL_WIDTH), jnp.float32), jnp.cumsum(pf, axis=1)], axis=1)
    t = jnp.arange(S)
    outs = []
    for g, w in enumerate(POOL_WINDOWS):
        lo_c, hi_c = g * POOL_GROUP_DIM, (g + 1) * POOL_GROUP_DIM
        csg = cs[:, :, lo_c:hi_c]
        upper = csg[:, 1:]
        lower = jnp.pad(csg[:, :S - w + 1], ((0, 0), (w - 1, 0), (0, 0)))
        count = jnp.minimum(t + 1, w).astype(jnp.float32)[None, :, None]
        outs.append((upper - lower) / count - pf[:, :, lo_c:hi_c])
    return jnp.stack(outs, axis=2)


def _hier_moe(u, w_group, b_group, w_router, b_router, w1, w3, w2):
    T = u.shape[0]
    gp = jax.nn.softmax((u @ w_group + b_group).astype(jnp.float32), axis=-1)
    g_prob, g_idx = lax.top_k(gp, 1)
    el = (u @ w_router + b_router).astype(jnp.float32).reshape(T, N_GROUPS, EXPERTS_PER_GROUP)
    sel = jnp.take_along_axis(el, g_idx[:, :, None], axis=1)[:, 0]
    top_v, top_i = lax.top_k(sel, TOP_K_INNER)
    cw = g_prob * jax.nn.softmax(top_v, axis=-1)
    within = jnp.einsum('tk,tke->te', cw, jax.nn.one_hot(top_i, EXPERTS_PER_GROUP, dtype=jnp.float32))
    gates = (jax.nn.one_hot(g_idx[:, 0], N_GROUPS, dtype=jnp.float32)[:, :, None] * within[:, None, :]).astype(u.dtype)
    y = jnp.zeros_like(u)
    for grp in range(N_GROUPS):
        h = jax.nn.silu(jnp.einsum('td,edf->tef', u, w1[grp])) * jnp.einsum('td,edf->tef', u, w3[grp])
        h = h * gates[:, grp, :, None]
        y = y + jnp.einsum('tef,efd->td', h, w2[grp])
    return y


def setup_inputs(seed: int = 0) -> dict:
    key = jax.random.key(seed)
    ks = jax.random.split(key, 24)
    D = D_MODEL
    nrm = jax.random.normal
    col_gain = jnp.concatenate([
        jnp.ones((2 * RET_WIDTH,), jnp.float32),
        jnp.full((RET_WIDTH,), BETA, jnp.float32),
        jnp.ones((RET_WIDTH,), jnp.float32),
        jnp.full((POOL_WIDTH,), BETA, jnp.float32),
    ])
    return {
        "x": nrm(ks[0], (BATCH, SEQ, D), jnp.float32),
        "c": nrm(ks[1], (BATCH, D), jnp.float32),
        "positions": jnp.broadcast_to(jnp.arange(SEQ, dtype=jnp.int32), (BATCH, SEQ)),
        "w_ada": nrm(ks[2], (DEPTH, D, 6 * D), jnp.float32) * D ** -0.5,
        "b_ada": 0.02 * nrm(ks[3], (DEPTH, 6 * D), jnp.float32),
        "w_in": nrm(ks[4], (DEPTH, D, IN_COLS), jnp.float32) * D ** -0.5 * col_gain,
        "ret_gn_w": 1.0 + 0.02 * nrm(ks[5], (DEPTH, RET_WIDTH), jnp.float32),
        "w_pool": nrm(ks[6], (DEPTH, POOL_GROUPS, POOL_GROUP_DIM, POOL_GROUP_DIM), jnp.float32) * POOL_GROUP_DIM ** -0.5,
        "pool_scale": 1.0 + 0.02 * nrm(ks[7], (DEPTH, POOL_WIDTH), jnp.float32),
        "w_out": nrm(ks[8], (DEPTH, D_MIX, D), jnp.float32) * D_MIX ** -0.5 * BETA,
        "ln1_w": 1.0 + 0.02 * nrm(ks[9], (DEPTH, D), jnp.float32),
        "ln1_b": 0.02 * nrm(ks[10], (DEPTH, D), jnp.float32),
        "w_group": nrm(ks[11], (DEPTH, D, N_GROUPS), jnp.float32) * D ** -0.5,
        "b_group": 0.01 * nrm(ks[12], (DEPTH, N_GROUPS), jnp.float32),
        "w_router": nrm(ks[13], (DEPTH, D, N_EXPERTS), jnp.float32) * D ** -0.5,
        "b_router": 0.01 * nrm(ks[14], (DEPTH, N_EXPERTS), jnp.float32),
        "w1": nrm(ks[15], (DEPTH, N_GROUPS, EXPERTS_PER_GROUP, D, D_EXPERT), jnp.float32) * D ** -0.5 * BETA,
        "w3": nrm(ks[16], (DEPTH, N_GROUPS, EXPERTS_PER_GROUP, D, D_EXPERT), jnp.float32) * D ** -0.5 * BETA,
        "w2": nrm(ks[17], (DEPTH, N_GROUPS, EXPERTS_PER_GROUP, D_EXPERT, D), jnp.float32) * D_EXPERT ** -0.5 * BETA,
        "ln2_w": 1.0 + 0.02 * nrm(ks[18], (DEPTH, D), jnp.float32),
        "ln2_b": 0.02 * nrm(ks[19], (DEPTH, D), jnp.float32),
    }


def reference(x, c, positions, w_ada, b_ada, w_in, ret_gn_w, w_pool, pool_scale, w_out,
              ln1_w, ln1_b, w_group, b_group, w_router, b_router, w1, w3, w2, ln2_w, ln2_b):
    B, S, D = x.shape
    inv_freq = ROPE_BASE ** (-jnp.arange(0, RET_HEAD_DIM, 2, dtype=jnp.float32) / RET_HEAD_DIM)
    ang = positions.astype(jnp.float32)[..., None] * inv_freq
    cos, sin = jnp.cos(ang)[:, :, None, :], jnp.sin(ang)[:, :, None, :]
    c_act = jax.nn.silu(c)
    for l in range(DEPTH):
        ada = (c_act @ w_ada[l] + b_ada[l])[:, None, :]
        shift1, scale1, gate1, shift2, scale2, gate2 = jnp.split(ada, 6, axis=-1)

        u = _layer_norm(x) * (1.0 + scale1) + shift1
        proj = u @ w_in[l]
        q, k, v, g, p = jnp.split(proj, [RET_WIDTH, 2 * RET_WIDTH, 3 * RET_WIDTH, 4 * RET_WIDTH], axis=-1)
        hs = (B, S, RET_HEADS, RET_HEAD_DIM)
        qr = _rotary(q.reshape(hs).astype(jnp.float32), cos, sin)
        kr = _rotary(k.reshape(hs).astype(jnp.float32), cos, sin) * RET_HEAD_DIM ** -0.5
        r = _retention(qr, kr, v.reshape(hs).astype(jnp.float32))
        r_mu = jnp.mean(r, axis=-1, keepdims=True)
        r_var = jnp.mean(jnp.square(r - r_mu), axis=-1, keepdims=True)
        r = ((r - r_mu) * lax.rsqrt(r_var + LN_EPS)).reshape(B, S, RET_WIDTH) * ret_gn_w[l]
        ret_out = jax.nn.silu(g) * r.astype(x.dtype)

        pooled = _multi_scale_pool(p).astype(x.dtype)
        pool_out = jnp.einsum('bsgc,gcd->bsgd', pooled, w_pool[l]).reshape(B, S, POOL_WIDTH) * pool_scale[l]

        mix = jnp.concatenate([ret_out, pool_out], axis=-1) @ w_out[l]
        x = _layer_norm(ALPHA * x + gate1 * mix, ln1_w[l], ln1_b[l])

        u2 = _layer_norm(x) * (1.0 + scale2) + shift2
        y = _hier_moe(u2.reshape(B * S, D), w_group[l], b_group[l], w_router[l], b_router[l],
                      w1[l], w3[l], w2[l]).reshape(B, S, D)
        x = _layer_norm(ALPHA * x + gate2 * y, ln2_w[l], ln2_b[l])
    return x
```

```cpp
#include <hip/hip_runtime.h>
#include <cstdio>
#include <cstdint>

constexpr int NB = 8, SEQ = 2048, D = 1024, T = NB * SEQ;
constexpr int RW = 512, PW = 512, RH = 4, RD = 128;
constexpr int INC = 2560;
constexpr int NGRP = 4, EPG = 8, NE = 32, DE = 256;
constexpr int ADA = 6 * D;
constexpr float ALPHA = 1.189207115002721f;
constexpr float LN_EPS = 1e-5f;
constexpr int NWG = 256, NTHR = 512;

constexpr size_t MiB = 1u << 20;
constexpr size_t WS_CTL = 0, CTL_ZERO_BYTES = 64 * 1024;
constexpr size_t WS_ADAP = 1 * MiB;
constexpr size_t WS_ADA = 2 * MiB + 512 * 1024;
constexpr size_t WS_TOKE = 3 * MiB;
constexpr size_t WS_TOKW = WS_TOKE + 128 * 1024;
constexpr size_t WS_ROT = 4 * MiB;
constexpr size_t WS_U = 68 * MiB;
constexpr size_t WS_PROJ = 100 * MiB;
constexpr size_t WS_V1 = 100 * MiB;
constexpr size_t WS_LOG = 180 * MiB;
constexpr size_t WS_MIX = 212 * MiB;
constexpr size_t WS_Y2 = 164 * MiB;
constexpr size_t WS_END = 256 * MiB;

typedef unsigned short bf16;
__device__ __forceinline__ unsigned f2bf(float f) { unsigned u = __builtin_bit_cast(unsigned, f); return (u + 0x7fffu + ((u >> 16) & 1u)) >> 16; }
__device__ __forceinline__ unsigned pk2(float lo, float hi) { return f2bf(lo) | (f2bf(hi) << 16); }
__device__ __forceinline__ float bflo(unsigned u) { return __builtin_bit_cast(float, u << 16); }
__device__ __forceinline__ float bfhi(unsigned u) { return __builtin_bit_cast(float, u & 0xffff0000u); }
__device__ __forceinline__ float bf2f(bf16 h) { return __builtin_bit_cast(float, (unsigned)h << 16); }
__device__ __forceinline__ float silu_f(float x) { return x / (1.0f + expf(-x)); }
__device__ __forceinline__ float wave_sum(float v) {
#pragma unroll
    for (int o = 1; o < 64; o <<= 1) v += __shfl_xor(v, o);
    return v;
}

struct Args { const void* in[21]; float* out; unsigned char* ws; int ph_lo, ph_hi, li, pad; };
enum { I_X = 0, I_C, I_POS, I_WADA, I_BADA, I_WIN, I_GNW, I_WPOOL, I_PSCALE, I_WOUT, I_LN1W, I_LN1B, I_WGRP, I_BGRP, I_WRT, I_BRT, I_W1, I_W3, I_W2, I_LN2W, I_LN2B };

template <class Epi>
__device__ __forceinline__ void naive_gemm(float* lds, const bf16* A, int lda, const float* W, int ldw, int M, int N, int K, const Epi& epi) {
    float* As = lds;
    float* Ws = lds + 16 * 132;
    const int tid = threadIdx.x, tx = tid & 31, ty = tid >> 5;
    const int ntn = N / 128, ntiles = (M / 128) * ntn;
    for (int tile = blockIdx.x; tile < ntiles; tile += gridDim.x) {
        const int tm = tile / ntn, tn = tile % ntn, row0 = tm * 128, col0 = tn * 128;
        float acc[8][4];
#pragma unroll
        for (int i = 0; i < 8; ++i)
#pragma unroll
            for (int j = 0; j < 4; ++j) acc[i][j] = 0.f;
        for (int k0 = 0; k0 < K; k0 += 16) {
            { const int r = tid >> 2, kq = (tid & 3) * 4; const uint2 raw = *(const uint2*)(A + (size_t)(row0 + r) * lda + k0 + kq);
              As[(kq + 0) * 132 + r] = bflo(raw.x); As[(kq + 1) * 132 + r] = bfhi(raw.x); As[(kq + 2) * 132 + r] = bflo(raw.y); As[(kq + 3) * 132 + r] = bfhi(raw.y); }
            { const int k = tid >> 5, n4 = (tid & 31) * 4; *(float4*)(Ws + k * 132 + n4) = *(const float4*)(W + (size_t)(k0 + k) * ldw + col0 + n4); }
            __syncthreads();
#pragma unroll
            for (int k = 0; k < 16; ++k) {
                const float4 a0 = *(const float4*)(As + k * 132 + ty * 8), a1 = *(const float4*)(As + k * 132 + ty * 8 + 4);
                const float4 w = *(const float4*)(Ws + k * 132 + tx * 4);
                const float av[8] = {a0.x, a0.y, a0.z, a0.w, a1.x, a1.y, a1.z, a1.w};
#pragma unroll
                for (int i = 0; i < 8; ++i) { acc[i][0] += av[i] * w.x; acc[i][1] += av[i] * w.y; acc[i][2] += av[i] * w.z; acc[i][3] += av[i] * w.w; }
            }
            __syncthreads();
        }
#pragma unroll
        for (int i = 0; i < 8; ++i) epi(row0 + ty * 8 + i, col0 + tx * 4, make_float4(acc[i][0], acc[i][1], acc[i][2], acc[i][3]));
    }
}

__device__ __forceinline__ void ph_ada_partial(float* lds, const float* c, const float* w_ada, float* part) {
    const int w = blockIdx.x, tid = threadIdx.x;
    if (w >= 96) return;
    const int cb = w % 12, kr = w / 12, c4 = tid & 127, ks = tid >> 7;
    float* cact = lds;
    float4* red = (float4*)(lds + 1024);
    for (int i = tid; i < 1024; i += NTHR) { const int b = i >> 7, kk = i & 127; cact[i] = silu_f(c[b * D + kr * 128 + kk]); }
    __syncthreads();
    float4 acc[8];
#pragma unroll
    for (int b = 0; b < 8; ++b) acc[b] = make_float4(0.f, 0.f, 0.f, 0.f);
    const int col = (cb * 128 + c4) * 4;
    for (int kk = 0; kk < 32; ++kk) {
        const int kl = ks * 32 + kk;
        const float4 wv = *(const float4*)(w_ada + (size_t)(kr * 128 + kl) * ADA + col);
#pragma unroll
        for (int b = 0; b < 8; ++b) { const float a = cact[b * 128 + kl]; acc[b].x += a * wv.x; acc[b].y += a * wv.y; acc[b].z += a * wv.z; acc[b].w += a * wv.w; }
    }
#pragma unroll
    for (int b = 0; b < 8; ++b) red[(ks * 8 + b) * 128 + c4] = acc[b];
    __syncthreads();
    for (int i = tid; i < 1024; i += NTHR) {
        const int b = i >> 7, cc = i & 127;
        float4 s = red[(0 * 8 + b) * 128 + cc];
#pragma unroll
        for (int q = 1; q < 4; ++q) { const float4 v = red[(q * 8 + b) * 128 + cc]; s.x += v.x; s.y += v.y; s.z += v.z; s.w += v.w; }
        *(float4*)(part + ((size_t)kr * 8 + b) * ADA + (cb * 128 + cc) * 4) = s;
    }
}
__device__ __forceinline__ void ph_rot_table(const int* pos, float2* rot) {
    const int gt = blockIdx.x * NTHR + threadIdx.x, GT = gridDim.x * NTHR;
    for (int idx = gt; idx < T * 64; idx += GT) {
        const int t = idx >> 6, i = idx & 63;
        const double inv = exp2(-(double)i * (13.287712379549449 / 64.0));
        const double ang = (double)pos[t] * inv;
        const double k = rint(ang * 0.15915494309189535);
        double r = fma(-k, 6.283185307179586, ang); r = fma(-k, 2.4492935982947064e-16, r);
        const float rf = (float)r;
        rot[idx] = make_float2(cosf(rf), sinf(rf));
    }
}
__device__ __forceinline__ void ph_ada_final_lnmod(float* lds, const float* x, const float* part, const float* b_ada, float* ada, bf16* U) {
    const int w = blockIdx.x, tid = threadIdx.x, lane = tid & 63, wave = tid >> 6, b = w >> 5;
    float* sh1 = lds; float* sc1 = lds + 1024;
    for (int j = tid; j < 2048; j += NTHR) { float s = b_ada[j]; for (int kr = 0; kr < 8; ++kr) s += part[((size_t)kr * 8 + b) * ADA + j]; if (j < 1024) sh1[j] = s; else sc1[j - 1024] = 1.0f + s; }
    { const int j0 = (w & 31) * 192; for (int j = tid; j < 192; j += NTHR) { float s = b_ada[j0 + j]; for (int kr = 0; kr < 8; ++kr) s += part[((size_t)kr * 8 + b) * ADA + j0 + j]; ada[(size_t)b * ADA + j0 + j] = s; } }
    __syncthreads();
    for (int i = 0; i < 8; ++i) {
        const int row = w * 64 + wave * 8 + i;
        const float4* xr = (const float4*)(x + (size_t)row * D) + lane;
        float4 v[4]; float s = 0.f;
#pragma unroll
        for (int j = 0; j < 4; ++j) { v[j] = xr[64 * j]; s += (v[j].x + v[j].y) + (v[j].z + v[j].w); }
        const float mean = wave_sum(s) * (1.f / D); float s2 = 0.f;
#pragma unroll
        for (int j = 0; j < 4; ++j) { v[j].x -= mean; v[j].y -= mean; v[j].z -= mean; v[j].w -= mean; s2 += (v[j].x * v[j].x + v[j].y * v[j].y) + (v[j].z * v[j].z + v[j].w * v[j].w); }
        const float rstd = 1.f / sqrtf(wave_sum(s2) * (1.f / D) + LN_EPS);
        uint2* o = (uint2*)(U + (size_t)row * D) + lane;
#pragma unroll
        for (int j = 0; j < 4; ++j) { const float4 sc = *(const float4*)(sc1 + 4 * lane + 256 * j), sh = *(const float4*)(sh1 + 4 * lane + 256 * j);
            o[64 * j] = make_uint2(pk2(v[j].x * rstd * sc.x + sh.x, v[j].y * rstd * sc.y + sh.y), pk2(v[j].z * rstd * sc.z + sh.z, v[j].w * rstd * sc.w + sh.w)); }
    }
}
__device__ __forceinline__ void ph_ret_naive(float* lds, const bf16* proj, const float2* rot, const float* gnw, bf16* mix) {
    const int w = blockIdx.x, tid = threadIdx.x;
    if (w >= 32) return;
    const int b = w >> 2, h = w & 3, e = tid & 127, dg = tid >> 7;
    const float gamma = 1.0f - exp2f(-5.0f - (float)h);
    float* Q = lds;
    float* Kk = lds + 4096;
    float* V = lds + 8192;
    float* red = lds + 12288;
    float Sx[32];
#pragma unroll
    for (int i = 0; i < 32; ++i) Sx[i] = 0.f;
    for (int t0 = 0; t0 < SEQ; t0 += 32) {
        __syncthreads();
        for (int it = tid; it < 32 * 64; it += NTHR) {
            const int r = it >> 6, i = it & 63; const size_t row = (size_t)b * SEQ + t0 + r;
            const float2 cs = rot[row * 64 + i];
            const bf16* pr = proj + row * INC;
            const float q1 = bf2f(pr[h * 128 + i]), q2 = bf2f(pr[h * 128 + 64 + i]);
            const float k1 = bf2f(pr[512 + h * 128 + i]), k2 = bf2f(pr[512 + h * 128 + 64 + i]);
            Q[r * 128 + i] = q1 * cs.x - q2 * cs.y; Q[r * 128 + 64 + i] = q1 * cs.y + q2 * cs.x;
            Kk[r * 128 + i] = (k1 * cs.x - k2 * cs.y) * 0.08838834764831845f; Kk[r * 128 + 64 + i] = (k1 * cs.y + k2 * cs.x) * 0.08838834764831845f;
            V[r * 128 + i] = bf2f(pr[1024 + h * 128 + i]); V[r * 128 + 64 + i] = bf2f(pr[1024 + h * 128 + 64 + i]);
        }
        __syncthreads();
        for (int r = 0; r < 32; ++r) {
            const float ve = V[r * 128 + e]; float o = 0.f;
#pragma unroll
            for (int dd = 0; dd < 32; ++dd) { const int d = dg * 32 + dd; Sx[dd] = gamma * Sx[dd] + Kk[r * 128 + d] * ve; o += Q[r * 128 + d] * Sx[dd]; }
            red[(r * 4 + dg) * 128 + e] = o;
        }
        __syncthreads();
        { const int lane = tid & 63, wave = tid >> 6;
          for (int rr = 0; rr < 4; ++rr) { const int r = wave * 4 + rr; const size_t row = (size_t)b * SEQ + t0 + r;
              float v0 = 0.f, v1 = 0.f;
#pragma unroll
              for (int q = 0; q < 4; ++q) { v0 += red[(r * 4 + q) * 128 + lane]; v1 += red[(r * 4 + q) * 128 + 64 + lane]; }
              const float mean = wave_sum(v0 + v1) * (1.f / 128.f); v0 -= mean; v1 -= mean;
              const float rstd = 1.f / sqrtf(wave_sum(v0 * v0 + v1 * v1) * (1.f / 128.f) + LN_EPS);
              const bf16* pr = proj + row * INC + 1536 + h * 128;
              const float g0 = bf2f(pr[lane]), g1 = bf2f(pr[64 + lane]);
              bf16* mo = mix + row * D + h * 128;
              mo[lane] = (bf16)f2bf(silu_f(g0) * (v0 * rstd * gnw[h * 128 + lane])); mo[64 + lane] = (bf16)f2bf(silu_f(g1) * (v1 * rstd * gnw[h * 128 + 64 + lane])); } }
    }
}
__device__ __forceinline__ void ph_pool_naive(float* lds, const bf16* proj, const float* w_pool, const float* pscale, bf16* mix) {
    const int tid = threadIdx.x;
    float* P = lds;
    for (int unit = blockIdx.x; unit < 256 * 4; unit += gridDim.x) {
        const int rb = unit >> 2, g = unit & 3, win = 2 << g, row0 = rb * 64;
        __syncthreads();
        for (int it = tid; it < 64 * 128; it += NTHR) {
            const int r = it >> 7, cc = it & 127; const int row = row0 + r, s = row & (SEQ - 1);
            const int cnt = (s + 1 < win) ? (s + 1) : win;
            float sum = 0.f;
            for (int j = 0; j < cnt; ++j) sum += bf2f(proj[(size_t)(row - j) * INC + 2048 + g * 128 + cc]);
            P[it] = sum / (float)cnt - bf2f(proj[(size_t)row * INC + 2048 + g * 128 + cc]);
        }
        __syncthreads();
        const int d = tid & 127, rg = tid >> 7;
        float acc[16];
#pragma unroll
        for (int i = 0; i < 16; ++i) acc[i] = 0.f;
        for (int cc = 0; cc < 128; ++cc) { const float wv = w_pool[((size_t)g * 128 + cc) * 128 + d];
#pragma unroll
            for (int i = 0; i < 16; ++i) acc[i] += P[(rg * 16 + i) * 128 + cc] * wv; }
        const float ps = pscale[g * 128 + d];
#pragma unroll
        for (int i = 0; i < 16; ++i) mix[(size_t)(row0 + rg * 16 + i) * D + 512 + g * 128 + d] = (bf16)f2bf(acc[i] * ps);
    }
}
__device__ __forceinline__ void ph_ln1_ln2mod(float* V1, const float* ln1w, const float* ln1b, const float* ada, bf16* U2) {
    const int tid = threadIdx.x, lane = tid & 63, wave = tid >> 6;
    for (int row = blockIdx.x * 8 + wave; row < T; row += gridDim.x * 8) {
        const int b = row / SEQ;
        float4* xr = (float4*)(V1 + (size_t)row * D) + lane;
        float4 v[4]; float s = 0.f;
#pragma unroll
        for (int j = 0; j < 4; ++j) { v[j] = xr[64 * j]; s += (v[j].x + v[j].y) + (v[j].z + v[j].w); }
        float mean = wave_sum(s) * (1.f / D); float s2 = 0.f;
#pragma unroll
        for (int j = 0; j < 4; ++j) { v[j].x -= mean; v[j].y -= mean; v[j].z -= mean; v[j].w -= mean; s2 += (v[j].x * v[j].x + v[j].y * v[j].y) + (v[j].z * v[j].z + v[j].w * v[j].w); }
        float rstd = 1.f / sqrtf(wave_sum(s2) * (1.f / D) + LN_EPS);
        s = 0.f;
#pragma unroll
        for (int j = 0; j < 4; ++j) { const float4 lw = *((const float4*)ln1w + lane + 64 * j), lb = *((const float4*)ln1b + lane + 64 * j);
            v[j].x = v[j].x * rstd * lw.x + lb.x; v[j].y = v[j].y * rstd * lw.y + lb.y; v[j].z = v[j].z * rstd * lw.z + lb.z; v[j].w = v[j].w * rstd * lw.w + lb.w;
            xr[64 * j] = v[j]; s += (v[j].x + v[j].y) + (v[j].z + v[j].w); }
        mean = wave_sum(s) * (1.f / D); s2 = 0.f;
#pragma unroll
        for (int j = 0; j < 4; ++j) { v[j].x -= mean; v[j].y -= mean; v[j].z -= mean; v[j].w -= mean; s2 += (v[j].x * v[j].x + v[j].y * v[j].y) + (v[j].z * v[j].z + v[j].w * v[j].w); }
        rstd = 1.f / sqrtf(wave_sum(s2) * (1.f / D) + LN_EPS);
        const float* sh2 = ada + (size_t)b * ADA + 3 * D; const float* sc2 = ada + (size_t)b * ADA + 4 * D;
        uint2* o = (uint2*)(U2 + (size_t)row * D) + lane;
#pragma unroll
        for (int j = 0; j < 4; ++j) { const float4 sc = *((const float4*)sc2 + lane + 64 * j), sh = *((const float4*)sh2 + lane + 64 * j);
            o[64 * j] = make_uint2(pk2(v[j].x * rstd * (1.f + sc.x) + sh.x, v[j].y * rstd * (1.f + sc.y) + sh.y), pk2(v[j].z * rstd * (1.f + sc.z) + sh.z, v[j].w * rstd * (1.f + sc.w) + sh.w)); }
    }
}
__device__ __forceinline__ void ph_router_naive(float* lds, const bf16* U2, const float* wg, const float* wr, float* logits) {
    const int tid = threadIdx.x, tl = tid >> 3, jg = tid & 7;
    float* Wl = lds;
    for (int blk = blockIdx.x; blk < T / 64; blk += gridDim.x) {
        const int t = blk * 64 + tl;
        float acc[5] = {0.f, 0.f, 0.f, 0.f, 0.f};
        for (int kh = 0; kh < 2; ++kh) {
            __syncthreads();
            for (int it = tid; it < 512 * 36; it += NTHR) { const int k = it / 36, j = it % 36; Wl[it] = (j < 4) ? wg[(size_t)(kh * 512 + k) * 4 + j] : wr[(size_t)(kh * 512 + k) * 32 + (j - 4)]; }
            __syncthreads();
            for (int k = 0; k < 512; ++k) { const float u = bf2f(U2[(size_t)t * D + kh * 512 + k]);
#pragma unroll
                for (int i = 0; i < 5; ++i) { const int j = jg + 8 * i; if (j < 36) acc[i] += u * Wl[k * 36 + j]; } }
        }
#pragma unroll
        for (int i = 0; i < 5; ++i) { const int j = jg + 8 * i; if (j < 36) logits[(size_t)t * 64 + j] = acc[i]; }
    }
}
__device__ __forceinline__ void ph_route(const float* logits, int npart, const float* bg, const float* br, int* tok_e, float* tok_w) {
    const int gt = blockIdx.x * NTHR + threadIdx.x, GT = gridDim.x * NTHR;
    for (int t = gt; t < T; t += GT) {
        float gl[4];
#pragma unroll
        for (int j = 0; j < 4; ++j) { float s = bg[j]; for (int p = 0; p < npart; ++p) s += logits[((size_t)p * T + t) * 64 + j]; gl[j] = s; }
        int gi = 0; float gm = gl[0];
#pragma unroll
        for (int j = 1; j < 4; ++j) if (gl[j] > gm) { gm = gl[j]; gi = j; }
        float den = 0.f;
#pragma unroll
        for (int j = 0; j < 4; ++j) den += expf(gl[j] - gm);
        const float gprob = 1.0f / den;
        float el[8];
#pragma unroll
        for (int i = 0; i < 8; ++i) { float s = 0.f; for (int p = 0; p < npart; ++p) s += logits[((size_t)p * T + t) * 64 + 4 + gi * 8 + i]; el[i] = s + br[gi * 8 + i]; }
        int i0 = 0; float v0 = el[0];
#pragma unroll
        for (int i = 1; i < 8; ++i) if (el[i] > v0) { v0 = el[i]; i0 = i; }
        int i1 = -1; float v1 = 0.f;
#pragma unroll
        for (int i = 0; i < 8; ++i) if (i != i0 && (i1 < 0 || el[i] > v1)) { v1 = el[i]; i1 = i; }
        const float ex = expf(v1 - v0), inv = 1.0f / (1.0f + ex);
        tok_e[2 * t] = gi * 8 + i0; tok_e[2 * t + 1] = gi * 8 + i1;
        tok_w[2 * t] = gprob * inv; tok_w[2 * t + 1] = gprob * ex * inv;
    }
}
__device__ __forceinline__ void ph_moe_naive(float* lds, const bf16* U2, const int* tok_e, const float* tok_w, const float* w1, const float* w3, const float* w2, float* Y2) {
    const int tid = threadIdx.x;
    float* u = lds;
    float* pa = lds + 1024;
    float* pb = lds + 1536;
    float* hh = lds + 2048;
    for (int t = blockIdx.x; t < T; t += gridDim.x) {
        __syncthreads();
        for (int i = tid; i < D; i += NTHR) u[i] = bf2f(U2[(size_t)t * D + i]);
        float y0 = 0.f, y1 = 0.f;
        for (int k = 0; k < 2; ++k) {
            const int e = tok_e[2 * t + k]; const float wgt = tok_w[2 * t + k];
            __syncthreads();
            { const int f = tid & 255, hf = tid >> 8; const float* p1 = w1 + ((size_t)e * D + hf * 512) * DE + f; const float* p3 = w3 + ((size_t)e * D + hf * 512) * DE + f;
              float a = 0.f, bq = 0.f;
              for (int d = 0; d < 512; ++d) { const float uv = u[hf * 512 + d]; a += uv * p1[(size_t)d * DE]; bq += uv * p3[(size_t)d * DE]; }
              pa[hf * 256 + f] = a; pb[hf * 256 + f] = bq; }
            __syncthreads();
            if (tid < 256) { const float a = pa[tid] + pa[256 + tid], bq = pb[tid] + pb[256 + tid]; hh[tid] = silu_f(a) * bq * wgt; }
            __syncthreads();
            { const float* p2 = w2 + (size_t)e * DE * D + tid;
              for (int f = 0; f < 256; ++f) { const float hv = hh[f]; y0 += hv * p2[(size_t)f * D]; y1 += hv * p2[(size_t)f * D + 512]; } }
        }
        Y2[(size_t)t * D + tid] = y0; Y2[(size_t)t * D + 512 + tid] = y1;
    }
}
__device__ __forceinline__ void ph_final(const float* X1, const float* Y2, const float* ada, const float* ln2w, const float* ln2b, float* out) {
    const int tid = threadIdx.x, lane = tid & 63, wave = tid >> 6;
    for (int row = blockIdx.x * 8 + wave; row < T; row += gridDim.x * 8) {
        const int b = row / SEQ;
        const float4* xr = (const float4*)(X1 + (size_t)row * D) + lane; const float4* yr = (const float4*)(Y2 + (size_t)row * D) + lane;
        const float4* g2 = (const float4*)(ada + (size_t)b * ADA + 5 * D) + lane;
        float4 v[4]; float s = 0.f;
#pragma unroll
        for (int j = 0; j < 4; ++j) { const float4 xv = xr[64 * j], yv = yr[64 * j], gv = g2[64 * j];
            v[j].x = ALPHA * xv.x + gv.x * yv.x; v[j].y = ALPHA * xv.y + gv.y * yv.y; v[j].z = ALPHA * xv.z + gv.z * yv.z; v[j].w = ALPHA * xv.w + gv.w * yv.w; s += (v[j].x + v[j].y) + (v[j].z + v[j].w); }
        const float mean = wave_sum(s) * (1.f / D); float s2 = 0.f;
#pragma unroll
        for (int j = 0; j < 4; ++j) { v[j].x -= mean; v[j].y -= mean; v[j].z -= mean; v[j].w -= mean; s2 += (v[j].x * v[j].x + v[j].y * v[j].y) + (v[j].z * v[j].z + v[j].w * v[j].w); }
        const float rstd = 1.f / sqrtf(wave_sum(s2) * (1.f / D) + LN_EPS);
        float4* o = (float4*)(out + (size_t)row * D) + lane;
#pragma unroll
        for (int j = 0; j < 4; ++j) { const float4 lw = *((const float4*)ln2w + lane + 64 * j), lb = *((const float4*)ln2b + lane + 64 * j);
            o[64 * j] = make_float4(v[j].x * rstd * lw.x + lb.x, v[j].y * rstd * lw.y + lb.y, v[j].z * rstd * lw.z + lb.z, v[j].w * rstd * lw.w + lb.w); }
    }
}

struct EpiStoreBf16 { bf16* O; int ldc; __device__ __forceinline__ void operator()(int row, int col, float4 a) const { *(uint2*)(O + (size_t)row * ldc + col) = make_uint2(pk2(a.x, a.y), pk2(a.z, a.w)); } };
struct EpiV1 { const float* x; const float* ada; float* V1;
    __device__ __forceinline__ void operator()(int row, int col, float4 a) const { const int b = row / SEQ; const float4 xv = *(const float4*)(x + (size_t)row * D + col), g = *(const float4*)(ada + (size_t)b * ADA + 2 * D + col);
        *(float4*)(V1 + (size_t)row * D + col) = make_float4(ALPHA * xv.x + g.x * a.x, ALPHA * xv.y + g.y * a.y, ALPHA * xv.z + g.z * a.z, ALPHA * xv.w + g.w * a.w); } };

constexpr int LDS_BYTES = 147456;
constexpr int N_PHASES = 11;

__global__ void __launch_bounds__(NTHR, 2) mk_fwd(Args args) {
    extern __shared__ __attribute__((aligned(16))) unsigned char lds_raw[];
    float* lds = (float*)lds_raw;
    unsigned char* ws = args.ws;
    const float* x = (const float*)args.in[I_X];
    float* part = (float*)(ws + WS_ADAP); float* ada = (float*)(ws + WS_ADA);
    int* tok_e = (int*)(ws + WS_TOKE); float* tok_w = (float*)(ws + WS_TOKW);
    float2* rot = (float2*)(ws + WS_ROT);
    bf16* U = (bf16*)(ws + WS_U); bf16* PROJ = (bf16*)(ws + WS_PROJ); float* V1 = (float*)(ws + WS_V1);
    float* LOG = (float*)(ws + WS_LOG); bf16* MIX = (bf16*)(ws + WS_MIX); float* Y2 = (float*)(ws + WS_Y2);
    const int lo = args.ph_lo, hi = args.ph_hi;
#define IN(k) (lo <= (k) && (k) < hi)
    if (IN(0)) { ph_ada_partial(lds, (const float*)args.in[I_C], (const float*)args.in[I_WADA], part); ph_rot_table((const int*)args.in[I_POS], rot); }
    if (IN(1)) { ph_ada_final_lnmod(lds, x, part, (const float*)args.in[I_BADA], ada, U); }
    if (IN(2)) { naive_gemm(lds, U, D, (const float*)args.in[I_WIN], INC, T, INC, D, EpiStoreBf16{PROJ, INC}); }
    if (IN(3)) { ph_ret_naive(lds, PROJ, rot, (const float*)args.in[I_GNW], MIX); }
    if (IN(4)) { ph_pool_naive(lds, PROJ, (const float*)args.in[I_WPOOL], (const float*)args.in[I_PSCALE], MIX); }
    if (IN(5)) { naive_gemm(lds, MIX, D, (const float*)args.in[I_WOUT], D, T, D, D, EpiV1{x, ada, V1}); }
    if (IN(6)) { ph_ln1_ln2mod(V1, (const float*)args.in[I_LN1W], (const float*)args.in[I_LN1B], ada, U); }
    if (IN(7)) { ph_router_naive(lds, U, (const float*)args.in[I_WGRP], (const float*)args.in[I_WRT], LOG); }
    if (IN(8)) { ph_route(LOG, 1, (const float*)args.in[I_BGRP], (const float*)args.in[I_BRT], tok_e, tok_w); }
    if (IN(9)) { ph_moe_naive(lds, U, tok_e, tok_w, (const float*)args.in[I_W1], (const float*)args.in[I_W3], (const float*)args.in[I_W2], Y2); }
    if (IN(10)) { ph_final(V1, Y2, ada, (const float*)args.in[I_LN2W], (const float*)args.in[I_LN2B], args.out); }
#undef IN
}

extern "C" void kernel_launch(void* const* d_in, const int* in_sizes, int n_in, void* d_out, int out_size, void* d_ws, size_t ws_size, hipStream_t stream) {
    static int grid = 0;
    if (grid == 0) {
        if (n_in != 21 || in_sizes[0] != T * D || out_size != T * D || ws_size < WS_END) { fprintf(stderr, "kernel_launch: unexpected shapes (n_in %d, in0 %d, out %d, ws %zu)\n", n_in, n_in > 0 ? in_sizes[0] : -1, out_size, ws_size); grid = -1; return; }
        if (hipFuncSetAttribute((const void*)mk_fwd, hipFuncAttributeMaxDynamicSharedMemorySize, LDS_BYTES) != hipSuccess) { fprintf(stderr, "kernel_launch: hipFuncSetAttribute failed\n"); grid = -1; return; }
        int dev = 0, cus = 0, per_cu = 0;
        if (hipGetDevice(&dev) != hipSuccess || hipDeviceGetAttribute(&cus, hipDeviceAttributeMultiprocessorCount, dev) != hipSuccess) { grid = -1; return; }
        if (hipOccupancyMaxActiveBlocksPerMultiprocessor(&per_cu, (const void*)mk_fwd, NTHR, LDS_BYTES) != hipSuccess || per_cu < 1) { fprintf(stderr, "kernel_launch: occupancy query says %d blocks per CU\n", per_cu); (void)hipGetLastError(); per_cu = 1; }
        grid = cus;
        if (grid > NWG) grid = NWG;
    }
    if (grid < 0) return;
    Args a{};
    for (int i = 0; i < 21; ++i) a.in[i] = d_in[i];
    a.out = (float*)d_out; a.ws = (unsigned char*)d_ws;
    for (int ph = 0; ph < N_PHASES; ++ph) {
        a.ph_lo = ph; a.ph_hi = ph + 1; a.li = ph;
        hipLaunchKernelGGL(mk_fwd, dim3(grid), dim3(NTHR), LDS_BYTES, stream, a);
    }
}
```

```cpp
#include <hip/hip_runtime.h>
#include <cstdio>
#include <cstdint>

constexpr int NB = 8, SEQ = 2048, D = 1024, T = NB * SEQ;
constexpr int RW = 512, PW = 512, RH = 4, RD = 128;
constexpr int INC = 2560;
constexpr int NGRP = 4, EPG = 8, NE = 32, DE = 256;
constexpr int ADA = 6 * D;
constexpr float ALPHA = 1.189207115002721f;
constexpr float LN_EPS = 1e-5f;
constexpr int NWG = 256, NTHR = 512;

constexpr size_t MiB = 1u << 20;
constexpr size_t WS_CTL = 0, CTL_ZERO_BYTES = 64 * 1024;
constexpr size_t WS_ADAP = 1 * MiB;
constexpr size_t WS_ADA = 2 * MiB + 512 * 1024;
constexpr size_t WS_TOKE = 3 * MiB;
constexpr size_t WS_TOKW = WS_TOKE + 128 * 1024;
constexpr size_t WS_ROT = 4 * MiB;
constexpr size_t WS_U = 68 * MiB;
constexpr size_t WS_PROJ = 100 * MiB;
constexpr size_t WS_V1 = 100 * MiB;
constexpr size_t WS_LOG = 180 * MiB;
constexpr size_t WS_MIX = 212 * MiB;
constexpr size_t WS_Y2 = 164 * MiB;
constexpr size_t WS_END = 256 * MiB;

typedef unsigned short bf16;
__device__ __forceinline__ unsigned f2bf(float f) { unsigned u = __builtin_bit_cast(unsigned, f); return (u + 0x7fffu + ((u >> 16) & 1u)) >> 16; }
__device__ __forceinline__ unsigned pk2(float lo, float hi) { return f2bf(lo) | (f2bf(hi) << 16); }
__device__ __forceinline__ float bflo(unsigned u) { return __builtin_bit_cast(float, u << 16); }
__device__ __forceinline__ float bfhi(unsigned u) { return __builtin_bit_cast(float, u & 0xffff0000u); }
__device__ __forceinline__ float bf2f(bf16 h) { return __builtin_bit_cast(float, (unsigned)h << 16); }
__device__ __forceinline__ float silu_f(float x) { return x / (1.0f + expf(-x)); }
__device__ __forceinline__ float wave_sum(float v) {
#pragma unroll
    for (int o = 1; o < 64; o <<= 1) v += __shfl_xor(v, o);
    return v;
}

struct Args { const void* in[21]; float* out; unsigned char* ws; int ph_lo, ph_hi, li, pad; };
enum { I_X = 0, I_C, I_POS, I_WADA, I_BADA, I_WIN, I_GNW, I_WPOOL, I_PSCALE, I_WOUT, I_LN1W, I_LN1B, I_WGRP, I_BGRP, I_WRT, I_BRT, I_W1, I_W3, I_W2, I_LN2W, I_LN2B };

template <class Epi>
__device__ __forceinline__ void naive_gemm(float* lds, const bf16* A, int lda, const float* W, int ldw, int M, int N, int K, const Epi& epi) {
    float* As = lds;
    float* Ws = lds + 16 * 132;
    const int tid = threadIdx.x, tx = tid & 31, ty = tid >> 5;
    const int ntn = N / 128, ntiles = (M / 128) * ntn;
    for (int tile = blockIdx.x; tile < ntiles; tile += gridDim.x) {
        const int tm = tile / ntn, tn = tile % ntn, row0 = tm * 128, col0 = tn * 128;
        float acc[8][4];
#pragma unroll
        for (int i = 0; i < 8; ++i)
#pragma unroll
            for (int j = 0; j < 4; ++j) acc[i][j] = 0.f;
        for (int k0 = 0; k0 < K; k0 += 16) {
            { const int r = tid >> 2, kq = (tid & 3) * 4; const uint2 raw = *(const uint2*)(A + (size_t)(row0 + r) * lda + k0 + kq);
              As[(kq + 0) * 132 + r] = bflo(raw.x); As[(kq + 1) * 132 + r] = bfhi(raw.x); As[(kq + 2) * 132 + r] = bflo(raw.y); As[(kq + 3) * 132 + r] = bfhi(raw.y); }
            { const int k = tid >> 5, n4 = (tid & 31) * 4; *(float4*)(Ws + k * 132 + n4) = *(const float4*)(W + (size_t)(k0 + k) * ldw + col0 + n4); }
            __syncthreads();
#pragma unroll
            for (int k = 0; k < 16; ++k) {
                const float4 a0 = *(const float4*)(As + k * 132 + ty * 8), a1 = *(const float4*)(As + k * 132 + ty * 8 + 4);
                const float4 w = *(const float4*)(Ws + k * 132 + tx * 4);
                const float av[8] = {a0.x, a0.y, a0.z, a0.w, a1.x, a1.y, a1.z, a1.w};
#pragma unroll
                for (int i = 0; i < 8; ++i) { acc[i][0] += av[i] * w.x; acc[i][1] += av[i] * w.y; acc[i][2] += av[i] * w.z; acc[i][3] += av[i] * w.w; }
            }
            __syncthreads();
        }
#pragma unroll
        for (int i = 0; i < 8; ++i) epi(row0 + ty * 8 + i, col0 + tx * 4, make_float4(acc[i][0], acc[i][1], acc[i][2], acc[i][3]));
    }
}

__device__ __forceinline__ void ph_ada_partial(float* lds, const float* c, const float* w_ada, float* part) {
    const int w = blockIdx.x, tid = threadIdx.x;
    if (w >= 96) return;
    const int cb = w % 12, kr = w / 12, c4 = tid & 127, ks = tid >> 7;
    float* cact = lds;
    float4* red = (float4*)(lds + 1024);
    for (int i = tid; i < 1024; i += NTHR) { const int b = i >> 7, kk = i & 127; cact[i] = silu_f(c[b * D + kr * 128 + kk]); }
    __syncthreads();
    float4 acc[8];
#pragma unroll
    for (int b = 0; b < 8; ++b) acc[b] = make_float4(0.f, 0.f, 0.f, 0.f);
    const int col = (cb * 128 + c4) * 4;
    for (int kk = 0; kk < 32; ++kk) {
        const int kl = ks * 32 + kk;
        const float4 wv = *(const float4*)(w_ada + (size_t)(kr * 128 + kl) * ADA + col);
#pragma unroll
        for (int b = 0; b < 8; ++b) { const float a = cact[b * 128 + kl]; acc[b].x += a * wv.x; acc[b].y += a * wv.y; acc[b].z += a * wv.z; acc[b].w += a * wv.w; }
    }
#pragma unroll
    for (int b = 0; b < 8; ++b) red[(ks * 8 + b) * 128 + c4] = acc[b];
    __syncthreads();
    for (int i = tid; i < 1024; i += NTHR) {
        const int b = i >> 7, cc = i & 127;
        float4 s = red[(0 * 8 + b) * 128 + cc];
#pragma unroll
        for (int q = 1; q < 4; ++q) { const float4 v = red[(q * 8 + b) * 128 + cc]; s.x += v.x; s.y += v.y; s.z += v.z; s.w += v.w; }
        *(float4*)(part + ((size_t)kr * 8 + b) * ADA + (cb * 128 + cc) * 4) = s;
    }
}
__device__ __forceinline__ void ph_rot_table(const int* pos, float2* rot) {
    const int gt = blockIdx.x * NTHR + threadIdx.x, GT = gridDim.x * NTHR;
    for (int idx = gt; idx < T * 64; idx += GT) {
        const int t = idx >> 6, i = idx & 63;
        const double inv = exp2(-(double)i * (13.287712379549449 / 64.0));
        const double ang = (double)pos[t] * inv;
        const double k = rint(ang * 0.15915494309189535);
        double r = fma(-k, 6.283185307179586, ang); r = fma(-k, 2.4492935982947064e-16, r);
        const float rf = (float)r;
        rot[idx] = make_float2(cosf(rf), sinf(rf));
    }
}
__device__ __forceinline__ void ph_ada_final_lnmod(float* lds, const float* x, const float* part, const float* b_ada, float* ada, bf16* U) {
    const int w = blockIdx.x, tid = threadIdx.x, lane = tid & 63, wave = tid >> 6, b = w >> 5;
    float* sh1 = lds; float* sc1 = lds + 1024;
    for (int j = tid; j < 2048; j += NTHR) { float s = b_ada[j]; for (int kr = 0; kr < 8; ++kr) s += part[((size_t)kr * 8 + b) * ADA + j]; if (j < 1024) sh1[j] = s; else sc1[j - 1024] = 1.0f + s; }
    { const int j0 = (w & 31) * 192; for (int j = tid; j < 192; j += NTHR) { float s = b_ada[j0 + j]; for (int kr = 0; kr < 8; ++kr) s += part[((size_t)kr * 8 + b) * ADA + j0 + j]; ada[(size_t)b * ADA + j0 + j] = s; } }
    __syncthreads();
    for (int i = 0; i < 8; ++i) {
        const int row = w * 64 + wave * 8 + i;
        const float4* xr = (const float4*)(x + (size_t)row * D) + lane;
        float4 v[4]; float s = 0.f;
#pragma unroll
        for (int j = 0; j < 4; ++j) { v[j] = xr[64 * j]; s += (v[j].x + v[j].y) + (v[j].z + v[j].w); }
        const float mean = wave_sum(s) * (1.f / D); float s2 = 0.f;
#pragma unroll
        for (int j = 0; j < 4; ++j) { v[j].x -= mean; v[j].y -= mean; v[j].z -= mean; v[j].w -= mean; s2 += (v[j].x * v[j].x + v[j].y * v[j].y) + (v[j].z * v[j].z + v[j].w * v[j].w); }
        const float rstd = 1.f / sqrtf(wave_sum(s2) * (1.f / D) + LN_EPS);
        uint2* o = (uint2*)(U + (size_t)row * D) + lane;
#pragma unroll
        for (int j = 0; j < 4; ++j) { const float4 sc = *(const float4*)(sc1 + 4 * lane + 256 * j), sh = *(const float4*)(sh1 + 4 * lane + 256 * j);
            o[64 * j] = make_uint2(pk2(v[j].x * rstd * sc.x + sh.x, v[j].y * rstd * sc.y + sh.y), pk2(v[j].z * rstd * sc.z + sh.z, v[j].w * rstd * sc.w + sh.w)); }
    }
}
__device__ __forceinline__ void ph_ret_naive(float* lds, const bf16* proj, const float2* rot, const float* gnw, bf16* mix) {
    const int w = blockIdx.x, tid = threadIdx.x;
    if (w >= 32) return;
    const int b = w >> 2, h = w & 3, e = tid & 127, dg = tid >> 7;
    const float gamma = 1.0f - exp2f(-5.0f - (float)h);
    float* Q = lds;
    float* Kk = lds + 4096;
    float* V = lds + 8192;
    float* red = lds + 12288;
    float Sx[32];
#pragma unroll
    for (int i = 0; i < 32; ++i) Sx[i] = 0.f;
    for (int t0 = 0; t0 < SEQ; t0 += 32) {
        __syncthreads();
        for (int it = tid; it < 32 * 64; it += NTHR) {
            const int r = it >> 6, i = it & 63; const size_t row = (size_t)b * SEQ + t0 + r;
            const float2 cs = rot[row * 64 + i];
            const bf16* pr = proj + row * INC;
            const float q1 = bf2f(pr[h * 128 + i]), q2 = bf2f(pr[h * 128 + 64 + i]);
            const float k1 = bf2f(pr[512 + h * 128 + i]), k2 = bf2f(pr[512 + h * 128 + 64 + i]);
            Q[r * 128 + i] = q1 * cs.x - q2 * cs.y; Q[r * 128 + 64 + i] = q1 * cs.y + q2 * cs.x;
            Kk[r * 128 + i] = (k1 * cs.x - k2 * cs.y) * 0.08838834764831845f; Kk[r * 128 + 64 + i] = (k1 * cs.y + k2 * cs.x) * 0.08838834764831845f;
            V[r * 128 + i] = bf2f(pr[1024 + h * 128 + i]); V[r * 128 + 64 + i] = bf2f(pr[1024 + h * 128 + 64 + i]);
        }
        __syncthreads();
        for (int r = 0; r < 32; ++r) {
            const float ve = V[r * 128 + e]; float o = 0.f;
#pragma unroll
            for (int dd = 0; dd < 32; ++dd) { const int d = dg * 32 + dd; Sx[dd] = gamma * Sx[dd] + Kk[r * 128 + d] * ve; o += Q[r * 128 + d] * Sx[dd]; }
            red[(r * 4 + dg) * 128 + e] = o;
        }
        __syncthreads();
        { const int lane = tid & 63, wave = tid >> 6;
          for (int rr = 0; rr < 4; ++rr) { const int r = wave * 4 + rr; const size_t row = (size_t)b * SEQ + t0 + r;
              float v0 = 0.f, v1 = 0.f;
#pragma unroll
              for (int q = 0; q < 4; ++q) { v0 += red[(r * 4 + q) * 128 + lane]; v1 += red[(r * 4 + q) * 128 + 64 + lane]; }
              const float mean = wave_sum(v0 + v1) * (1.f / 128.f); v0 -= mean; v1 -= mean;
              const float rstd = 1.f / sqrtf(wave_sum(v0 * v0 + v1 * v1) * (1.f / 128.f) + LN_EPS);
              const bf16* pr = proj + row * INC + 1536 + h * 128;
              const float g0 = bf2f(pr[lane]), g1 = bf2f(pr[64 + lane]);
              bf16* mo = mix + row * D + h * 128;
              mo[lane] = (bf16)f2bf(silu_f(g0) * (v0 * rstd * gnw[h * 128 + lane])); mo[64 + lane] = (bf16)f2bf(silu_f(g1) * (v1 * rstd * gnw[h * 128 + 64 + lane])); } }
    }
}
__device__ __forceinline__ void ph_pool_naive(float* lds, const bf16* proj, const float* w_pool, const float* pscale, bf16* mix) {
    const int tid = threadIdx.x;
    float* P = lds;
    for (int unit = blockIdx.x; unit < 256 * 4; unit += gridDim.x) {
        const int rb = unit >> 2, g = unit & 3, win = 2 << g, row0 = rb * 64;
        __syncthreads();
        for (int it = tid; it < 64 * 128; it += NTHR) {
            const int r = it >> 7, cc = it & 127; const int row = row0 + r, s = row & (SEQ - 1);
            const int cnt = (s + 1 < win) ? (s + 1) : win;
            float sum = 0.f;
            for (int j = 0; j < cnt; ++j) sum += bf2f(proj[(size_t)(row - j) * INC + 2048 + g * 128 + cc]);
            P[it] = sum / (float)cnt - bf2f(proj[(size_t)row * INC + 2048 + g * 128 + cc]);
        }
        __syncthreads();
        const int d = tid & 127, rg = tid >> 7;
        float acc[16];
#pragma unroll
        for (int i = 0; i < 16; ++i) acc[i] = 0.f;
        for (int cc = 0; cc < 128; ++cc) { const float wv = w_pool[((size_t)g * 128 + cc) * 128 + d];
#pragma unroll
            for (int i = 0; i < 16; ++i) acc[i] += P[(rg * 16 + i) * 128 + cc] * wv; }
        const float ps = pscale[g * 128 + d];
#pragma unroll
        for (int i = 0; i < 16; ++i) mix[(size_t)(row0 + rg * 16 + i) * D + 512 + g * 128 + d] = (bf16)f2bf(acc[i] * ps);
    }
}
__device__ __forceinline__ void ph_ln1_ln2mod(float* V1, const float* ln1w, const float* ln1b, const float* ada, bf16* U2) {
    const int tid = threadIdx.x, lane = tid & 63, wave = tid >> 6;
    for (int row = blockIdx.x * 8 + wave; row < T; row += gridDim.x * 8) {
        const int b = row / SEQ;
        float4* xr = (float4*)(V1 + (size_t)row * D) + lane;
        float4 v[4]; float s = 0.f;
#pragma unroll
        for (int j = 0; j < 4; ++j) { v[j] = xr[64 * j]; s += (v[j].x + v[j].y) + (v[j].z + v[j].w); }
        float mean = wave_sum(s) * (1.f / D); float s2 = 0.f;
#pragma unroll
        for (int j = 0; j < 4; ++j) { v[j].x -= mean; v[j].y -= mean; v[j].z -= mean; v[j].w -= mean; s2 += (v[j].x * v[j].x + v[j].y * v[j].y) + (v[j].z * v[j].z + v[j].w * v[j].w); }
        float rstd = 1.f / sqrtf(wave_sum(s2) * (1.f / D) + LN_EPS);
        s = 0.f;
#pragma unroll
        for (int j = 0; j < 4; ++j) { const float4 lw = *((const float4*)ln1w + lane + 64 * j), lb = *((const float4*)ln1b + lane + 64 * j);
            v[j].x = v[j].x * rstd * lw.x + lb.x; v[j].y = v[j].y * rstd * lw.y + lb.y; v[j].z = v[j].z * rstd * lw.z + lb.z; v[j].w = v[j].w * rstd * lw.w + lb.w;
            xr[64 * j] = v[j]; s += (v[j].x + v[j].y) + (v[j].z + v[j].w); }
        mean = wave_sum(s) * (1.f / D); s2 = 0.f;
#pragma unroll
        for (int j = 0; j < 4; ++j) { v[j].x -= mean; v[j].y -= mean; v[j].z -= mean; v[j].w -= mean; s2 += (v[j].x * v[j].x + v[j].y * v[j].y) + (v[j].z * v[j].z + v[j].w * v[j].w); }
        rstd = 1.f / sqrtf(wave_sum(s2) * (1.f / D) + LN_EPS);
        const float* sh2 = ada + (size_t)b * ADA + 3 * D; const float* sc2 = ada + (size_t)b * ADA + 4 * D;
        uint2* o = (uint2*)(U2 + (size_t)row * D) + lane;
#pragma unroll
        for (int j = 0; j < 4; ++j) { const float4 sc = *((const float4*)sc2 + lane + 64 * j), sh = *((const float4*)sh2 + lane + 64 * j);
            o[64 * j] = make_uint2(pk2(v[j].x * rstd * (1.f + sc.x) + sh.x, v[j].y * rstd * (1.f + sc.y) + sh.y), pk2(v[j].z * rstd * (1.f + sc.z) + sh.z, v[j].w * rstd * (1.f + sc.w) + sh.w)); }
    }
}
__device__ __forceinline__ void ph_router_naive(float* lds, const bf16* U2, const float* wg, const float* wr, float* logits) {
    const int tid = threadIdx.x, tl = tid >> 3, jg = tid & 7;
    float* Wl = lds;
    for (int blk = blockIdx.x; blk < T / 64; blk += gridDim.x) {
        const int t = blk * 64 + tl;
        float acc[5] = {0.f, 0.f, 0.f, 0.f, 0.f};
        for (int kh = 0; kh < 2; ++kh) {
            __syncthreads();
            for (int it = tid; it < 512 * 36; it += NTHR) { const int k = it / 36, j = it % 36; Wl[it] = (j < 4) ? wg[(size_t)(kh * 512 + k) * 4 + j] : wr[(size_t)(kh * 512 + k) * 32 + (j - 4)]; }
            __syncthreads();
            for (int k = 0; k < 512; ++k) { const float u = bf2f(U2[(size_t)t * D + kh * 512 + k]);
#pragma unroll
                for (int i = 0; i < 5; ++i) { const int j = jg + 8 * i; if (j < 36) acc[i] += u * Wl[k * 36 + j]; } }
        }
#pragma unroll
        for (int i = 0; i < 5; ++i) { const int j = jg + 8 * i; if (j < 36) logits[(size_t)t * 64 + j] = acc[i]; }
    }
}
__device__ __forceinline__ void ph_route(const float* logits, int npart, const float* bg, const float* br, int* tok_e, float* tok_w) {
    const int gt = blockIdx.x * NTHR + threadIdx.x, GT = gridDim.x * NTHR;
    for (int t = gt; t < T; t += GT) {
        float gl[4];
#pragma unroll
        for (int j = 0; j < 4; ++j) { float s = bg[j]; for (int p = 0; p < npart; ++p) s += logits[((size_t)p * T + t) * 64 + j]; gl[j] = s; }
        int gi = 0; float gm = gl[0];
#pragma unroll
        for (int j = 1; j < 4; ++j) if (gl[j] > gm) { gm = gl[j]; gi = j; }
        float den = 0.f;
#pragma unroll
        for (int j = 0; j < 4; ++j) den += expf(gl[j] - gm);
        const float gprob = 1.0f / den;
        float el[8];
#pragma unroll
        for (int i = 0; i < 8; ++i) { float s = 0.f; for (int p = 0; p < npart; ++p) s += logits[((size_t)p * T + t) * 64 + 4 + gi * 8 + i]; el[i] = s + br[gi * 8 + i]; }
        int i0 = 0; float v0 = el[0];
#pragma unroll
        for (int i = 1; i < 8; ++i) if (el[i] > v0) { v0 = el[i]; i0 = i; }
        int i1 = -1; float v1 = 0.f;
#pragma unroll
        for (int i = 0; i < 8; ++i) if (i != i0 && (i1 < 0 || el[i] > v1)) { v1 = el[i]; i1 = i; }
        const float ex = expf(v1 - v0), inv = 1.0f / (1.0f + ex);
        tok_e[2 * t] = gi * 8 + i0; tok_e[2 * t + 1] = gi * 8 + i1;
        tok_w[2 * t] = gprob * inv; tok_w[2 * t + 1] = gprob * ex * inv;
    }
}
__device__ __forceinline__ void ph_moe_naive(float* lds, const bf16* U2, const int* tok_e, const float* tok_w, const float* w1, const float* w3, const float* w2, float* Y2) {
    const int tid = threadIdx.x;
    float* u = lds;
    float* pa = lds + 1024;
    float* pb = lds + 1536;
    float* hh = lds + 2048;
    for (int t = blockIdx.x; t < T; t += gridDim.x) {
        __syncthreads();
        for (int i = tid; i < D; i += NTHR) u[i] = bf2f(U2[(size_t)t * D + i]);
        float y0 = 0.f, y1 = 0.f;
        for (int k = 0; k < 2; ++k) {
            const int e = tok_e[2 * t + k]; const float wgt = tok_w[2 * t + k];
            __syncthreads();
            { const int f = tid & 255, hf = tid >> 8; const float* p1 = w1 + ((size_t)e * D + hf * 512) * DE + f; const float* p3 = w3 + ((size_t)e * D + hf * 512) * DE + f;
              float a = 0.f, bq = 0.f;
              for (int d = 0; d < 512; ++d) { const float uv = u[hf * 512 + d]; a += uv * p1[(size_t)d * DE]; bq += uv * p3[(size_t)d * DE]; }
              pa[hf * 256 + f] = a; pb[hf * 256 + f] = bq; }
            __syncthreads();
            if (tid < 256) { const float a = pa[tid] + pa[256 + tid], bq = pb[tid] + pb[256 + tid]; hh[tid] = silu_f(a) * bq * wgt; }
            __syncthreads();
            { const float* p2 = w2 + (size_t)e * DE * D + tid;
              for (int f = 0; f < 256; ++f) { const float hv = hh[f]; y0 += hv * p2[(size_t)f * D]; y1 += hv * p2[(size_t)f * D + 512]; } }
        }
        Y2[(size_t)t * D + tid] = y0; Y2[(size_t)t * D + 512 + tid] = y1;
    }
}
__device__ __forceinline__ void ph_final(const float* X1, const float* Y2, const float* ada, const float* ln2w, const float* ln2b, float* out) {
    const int tid = threadIdx.x, lane = tid & 63, wave = tid >> 6;
    for (int row = blockIdx.x * 8 + wave; row < T; row += gridDim.x * 8) {
        const int b = row / SEQ;
        const float4* xr = (const float4*)(X1 + (size_t)row * D) + lane; const float4* yr = (const float4*)(Y2 + (size_t)row * D) + lane;
        const float4* g2 = (const float4*)(ada + (size_t)b * ADA + 5 * D) + lane;
        float4 v[4]; float s = 0.f;
#pragma unroll
        for (int j = 0; j < 4; ++j) { const float4 xv = xr[64 * j], yv = yr[64 * j], gv = g2[64 * j];
            v[j].x = ALPHA * xv.x + gv.x * yv.x; v[j].y = ALPHA * xv.y + gv.y * yv.y; v[j].z = ALPHA * xv.z + gv.z * yv.z; v[j].w = ALPHA * xv.w + gv.w * yv.w; s += (v[j].x + v[j].y) + (v[j].z + v[j].w); }
        const float mean = wave_sum(s) * (1.f / D); float s2 = 0.f;
#pragma unroll
        for (int j = 0; j < 4; ++j) { v[j].x -= mean; v[j].y -= mean; v[j].z -= mean; v[j].w -= mean; s2 += (v[j].x * v[j].x + v[j].y * v[j].y) + (v[j].z * v[j].z + v[j].w * v[j].w); }
        const float rstd = 1.f / sqrtf(wave_sum(s2) * (1.f / D) + LN_EPS);
        float4* o = (float4*)(out + (size_t)row * D) + lane;
#pragma unroll
        for (int j = 0; j < 4; ++j) { const float4 lw = *((const float4*)ln2w + lane + 64 * j), lb = *((const float4*)ln2b + lane + 64 * j);
            o[64 * j] = make_float4(v[j].x * rstd * lw.x + lb.x, v[j].y * rstd * lw.y + lb.y, v[j].z * rstd * lw.z + lb.z, v[j].w * rstd * lw.w + lb.w); }
    }
}

struct EpiStoreBf16 { bf16* O; int ldc; __device__ __forceinline__ void operator()(int row, int col, float4 a) const { *(uint2*)(O + (size_t)row * ldc + col) = make_uint2(pk2(a.x, a.y), pk2(a.z, a.w)); } };
struct EpiV1 { const float* x; const float* ada; float* V1;
    __device__ __forceinline__ void operator()(int row, int col, float4 a) const { const int b = row / SEQ; const float4 xv = *(const float4*)(x + (size_t)row * D + col), g = *(const float4*)(ada + (size_t)b * ADA + 2 * D + col);
        *(float4*)(V1 + (size_t)row * D + col) = make_float4(ALPHA * xv.x + g.x * a.x, ALPHA * xv.y + g.y * a.y, ALPHA * xv.z + g.z * a.z, ALPHA * xv.w + g.w * a.w); } };


#define LAS __attribute__((address_space(3)))
#define XB_TMO      128
#define XB_XCNT(j)  (256  + 64 * (j))
#define XB_XSUB(j)  (1280 + 64 * (j))
#define XB_XGEN(j)  (2304 + 64 * (j))
#define XB_TOP      3328
#define XB_TOPGEN   3392
#define XCD_BAR_WORDS 3456
#define XB_SPIN_CAP (1u << 22)
__device__ __forceinline__ unsigned xb_ld(unsigned* p)              { return __hip_atomic_load(p, __ATOMIC_RELAXED, __HIP_MEMORY_SCOPE_AGENT); }
__device__ __forceinline__ unsigned xb_add(unsigned* p, unsigned v) { return __hip_atomic_fetch_add(p, v, __ATOMIC_RELAXED, __HIP_MEMORY_SCOPE_AGENT); }
__device__ __forceinline__ unsigned xb_xcc_id() { return (unsigned)__builtin_amdgcn_s_getreg((3 << 11) | 20) & 0xFu; }
#define XB_SPIN(cond, bar) do { unsigned _sp = 0; while (cond) { __builtin_amdgcn_s_sleep(1); \
    if ((++_sp & 255u) == 0u) { if (xb_ld(&(bar)[XB_TMO])) break; if (_sp > XB_SPIN_CAP) { atomicAdd(&(bar)[XB_TMO], 1u); break; } } } } while (0)
struct XcdBarrier { unsigned* bar; unsigned x; volatile LAS unsigned* st; };
__device__ __forceinline__ XcdBarrier xcd_barrier_post(unsigned* bar, volatile LAS unsigned* st) {
    XcdBarrier b; b.bar = bar; b.x = xb_xcc_id(); b.st = st;
    if (threadIdx.x == 0) (void)xb_add(&bar[XB_XCNT(b.x)], 1u);
    return b;
}
__device__ __forceinline__ void xcd_barrier_complete(unsigned* bar, unsigned x, unsigned& nloc, unsigned& nx) {
    const unsigned G = gridDim.x * gridDim.y * gridDim.z;
    unsigned sum, cnt, mine, sp = 0u;
    for (;;) {
        sum = 0u; cnt = 0u; mine = 0u;
#pragma unroll
        for (unsigned j = 0; j < 16; ++j) { const unsigned c = xb_ld(&bar[XB_XCNT(j)]); sum += c; cnt += (c > 0u) ? 1u : 0u; mine = (j == x) ? c : mine; }
        if (sum == G) break;
        __builtin_amdgcn_s_sleep(1);
        if ((++sp & 255u) == 0u) { if (xb_ld(&bar[XB_TMO])) break; if (sp > XB_SPIN_CAP) { atomicAdd(&bar[XB_TMO], 1u); break; } }
    }
    nloc = mine > 0u ? mine : 1u; nx = cnt > 0u ? cnt : 1u;
}
__device__ __forceinline__ void xcd_barrier(const XcdBarrier& b) {
    asm volatile("s_waitcnt vmcnt(0)" ::: "memory");
    __syncthreads();
    if (threadIdx.x == 0) {
        unsigned* bar = b.bar;
        __builtin_amdgcn_s_waitcnt(0);
        unsigned nloc = b.st[0], nx = b.st[1];
        if (nloc == 0u) { xcd_barrier_complete(bar, b.x, nloc, nx); b.st[0] = nloc; b.st[1] = nx; }
        const unsigned old = xb_add(&bar[XB_XSUB(b.x)], 1u);
        const unsigned gen = old / nloc;
        if (old + 1u == (gen + 1u) * nloc) {
            __builtin_amdgcn_fence(__ATOMIC_RELEASE, "agent");
            asm volatile("s_waitcnt vmcnt(0)" ::: "memory");
            const unsigned og = xb_add(&bar[XB_TOP], 1u);
            const unsigned tg = og / nx;
            if (og + 1u == (tg + 1u) * nx) xb_add(&bar[XB_TOPGEN], 1u);
            else XB_SPIN(xb_ld(&bar[XB_TOPGEN]) == tg, bar);
            __builtin_amdgcn_fence(__ATOMIC_ACQUIRE, "agent");
            xb_add(&bar[XB_XGEN(b.x)], 1u);
            asm volatile("s_waitcnt vmcnt(0)" ::: "memory");
        } else {
            XB_SPIN(xb_ld(&bar[XB_XGEN(b.x)]) == gen, bar);
            __builtin_amdgcn_fence(__ATOMIC_ACQUIRE, "agent");
            asm volatile("s_waitcnt vmcnt(0)" ::: "memory");
        }
    }
    __syncthreads();
}
constexpr int CW_BAR = 1024;

constexpr int LDS_BYTES = 147456;
constexpr int MISC_OFF = LDS_BYTES - 64;
constexpr int N_PHASES = 11;

__global__ void __launch_bounds__(NTHR, 2) mk_fwd(Args args) {
    extern __shared__ __attribute__((aligned(16))) unsigned char lds_raw[];
    float* lds = (float*)lds_raw;
    unsigned char* ws = args.ws;
    const float* x = (const float*)args.in[I_X];
    float* part = (float*)(ws + WS_ADAP); float* ada = (float*)(ws + WS_ADA);
    int* tok_e = (int*)(ws + WS_TOKE); float* tok_w = (float*)(ws + WS_TOKW);
    float2* rot = (float2*)(ws + WS_ROT);
    bf16* U = (bf16*)(ws + WS_U); bf16* PROJ = (bf16*)(ws + WS_PROJ); float* V1 = (float*)(ws + WS_V1);
    float* LOG = (float*)(ws + WS_LOG); bf16* MIX = (bf16*)(ws + WS_MIX); float* Y2 = (float*)(ws + WS_Y2);
    const int lo = args.ph_lo, hi = args.ph_hi;
    volatile LAS unsigned* MISC = (volatile LAS unsigned*)((LAS unsigned char*)lds_raw + MISC_OFF);
    if (threadIdx.x < 16) MISC[threadIdx.x] = 0u;
    __syncthreads();
    XcdBarrier bar; bar.bar = (unsigned*)(ws + WS_CTL) + CW_BAR; bar.x = 0; bar.st = nullptr;
    if (hi - lo > 1) bar = xcd_barrier_post((unsigned*)(ws + WS_CTL) + CW_BAR, MISC);
#define IN(k) (lo <= (k) && (k) < hi)
#define SEAM(k) do { if (IN(k) && IN((k) + 1)) xcd_barrier(bar); } while (0)
    if (IN(0)) { ph_ada_partial(lds, (const float*)args.in[I_C], (const float*)args.in[I_WADA], part); ph_rot_table((const int*)args.in[I_POS], rot); }
    SEAM(0);
    if (IN(1)) { ph_ada_final_lnmod(lds, x, part, (const float*)args.in[I_BADA], ada, U); }
    SEAM(1);
    if (IN(2)) { naive_gemm(lds, U, D, (const float*)args.in[I_WIN], INC, T, INC, D, EpiStoreBf16{PROJ, INC}); }
    SEAM(2);
    if (IN(3)) { ph_ret_naive(lds, PROJ, rot, (const float*)args.in[I_GNW], MIX); }
    SEAM(3);
    if (IN(4)) { ph_pool_naive(lds, PROJ, (const float*)args.in[I_WPOOL], (const float*)args.in[I_PSCALE], MIX); }
    SEAM(4);
    if (IN(5)) { naive_gemm(lds, MIX, D, (const float*)args.in[I_WOUT], D, T, D, D, EpiV1{x, ada, V1}); }
    SEAM(5);
    if (IN(6)) { ph_ln1_ln2mod(V1, (const float*)args.in[I_LN1W], (const float*)args.in[I_LN1B], ada, U); }
    SEAM(6);
    if (IN(7)) { ph_router_naive(lds, U, (const float*)args.in[I_WGRP], (const float*)args.in[I_WRT], LOG); }
    SEAM(7);
    if (IN(8)) { ph_route(LOG, 1, (const float*)args.in[I_BGRP], (const float*)args.in[I_BRT], tok_e, tok_w); }
    SEAM(8);
    if (IN(9)) { ph_moe_naive(lds, U, tok_e, tok_w, (const float*)args.in[I_W1], (const float*)args.in[I_W3], (const float*)args.in[I_W2], Y2); }
    SEAM(9);
    if (IN(10)) { ph_final(V1, Y2, ada, (const float*)args.in[I_LN2W], (const float*)args.in[I_LN2B], args.out); }
#undef IN
#undef SEAM
}

extern "C" void kernel_launch(void* const* d_in, const int* in_sizes, int n_in, void* d_out, int out_size, void* d_ws, size_t ws_size, hipStream_t stream) {
    static int grid = 0;
    if (grid == 0) {
        if (n_in != 21 || in_sizes[0] != T * D || out_size != T * D || ws_size < WS_END) { fprintf(stderr, "kernel_launch: unexpected shapes (n_in %d, in0 %d, out %d, ws %zu)\n", n_in, n_in > 0 ? in_sizes[0] : -1, out_size, ws_size); grid = -1; return; }
        if (hipFuncSetAttribute((const void*)mk_fwd, hipFuncAttributeMaxDynamicSharedMemorySize, LDS_BYTES) != hipSuccess) { fprintf(stderr, "kernel_launch: hipFuncSetAttribute failed\n"); grid = -1; return; }
        int dev = 0, cus = 0, per_cu = 0;
        if (hipGetDevice(&dev) != hipSuccess || hipDeviceGetAttribute(&cus, hipDeviceAttributeMultiprocessorCount, dev) != hipSuccess) { grid = -1; return; }
        if (hipOccupancyMaxActiveBlocksPerMultiprocessor(&per_cu, (const void*)mk_fwd, NTHR, LDS_BYTES) != hipSuccess || per_cu < 1) { fprintf(stderr, "kernel_launch: occupancy query says %d blocks per CU\n", per_cu); (void)hipGetLastError(); per_cu = 1; }
        grid = cus;
        if (grid > NWG) grid = NWG;
    }
    if (grid < 0) return;
    Args a{};
    for (int i = 0; i < 21; ++i) a.in[i] = d_in[i];
    a.out = (float*)d_out; a.ws = (unsigned char*)d_ws;
    if (hipMemsetAsync((char*)d_ws + WS_CTL, 0, CTL_ZERO_BYTES, stream) != hipSuccess) { fprintf(stderr, "kernel_launch: hipMemsetAsync failed\n"); return; }
    a.ph_lo = 0; a.ph_hi = N_PHASES; a.li = 0;
    hipLaunchKernelGGL(mk_fwd, dim3(grid), dim3(NTHR), LDS_BYTES, stream, a);
}
```

```cpp
#include <hip/hip_runtime.h>
#include <cstdio>
#include <cstdint>

constexpr int NB = 8, SEQ = 2048, D = 1024, T = NB * SEQ;
constexpr int RW = 512, PW = 512, RH = 4, RD = 128;
constexpr int INC = 2560;
constexpr int NGRP = 4, EPG = 8, NE = 32, DE = 256;
constexpr int ADA = 6 * D;
constexpr float ALPHA = 1.189207115002721f;
constexpr float LN_EPS = 1e-5f;
constexpr int NWG = 256, NTHR = 512;

constexpr size_t MiB = 1u << 20;
constexpr size_t WS_CTL = 0, CTL_ZERO_BYTES = 64 * 1024;
constexpr size_t WS_ADAP = 1 * MiB;
constexpr size_t WS_ADA = 2 * MiB + 512 * 1024;
constexpr size_t WS_TOKE = 3 * MiB;
constexpr size_t WS_TOKW = WS_TOKE + 128 * 1024;
constexpr size_t WS_ROT = 4 * MiB;
constexpr size_t WS_WR = 12 * MiB;
constexpr size_t WS_WPOOL = 12 * MiB + 512 * 1024;
constexpr size_t WS_WIN = 13 * MiB;
constexpr size_t WS_WOUT = 18 * MiB;
constexpr size_t WS_W13 = 20 * MiB;
constexpr size_t WS_W2 = 52 * MiB;
constexpr size_t WS_U = 68 * MiB;
constexpr size_t WS_PROJ = 100 * MiB;
constexpr size_t WS_V1 = 100 * MiB;
constexpr size_t WS_LOG = 180 * MiB;
constexpr size_t WS_MIX = 212 * MiB;
constexpr size_t WS_Y2 = 164 * MiB;
constexpr size_t WS_END = 256 * MiB;

typedef unsigned short bf16;
__device__ __forceinline__ unsigned f2bf(float f) { unsigned u = __builtin_bit_cast(unsigned, f); return (u + 0x7fffu + ((u >> 16) & 1u)) >> 16; }
__device__ __forceinline__ unsigned pk2(float lo, float hi) { return f2bf(lo) | (f2bf(hi) << 16); }
__device__ __forceinline__ float bflo(unsigned u) { return __builtin_bit_cast(float, u << 16); }
__device__ __forceinline__ float bfhi(unsigned u) { return __builtin_bit_cast(float, u & 0xffff0000u); }
__device__ __forceinline__ float bf2f(bf16 h) { return __builtin_bit_cast(float, (unsigned)h << 16); }
__device__ __forceinline__ float silu_f(float x) { return x / (1.0f + expf(-x)); }
__device__ __forceinline__ float wave_sum(float v) {
#pragma unroll
    for (int o = 1; o < 64; o <<= 1) v += __shfl_xor(v, o);
    return v;
}

struct Args { const void* in[21]; float* out; unsigned char* ws; int ph_lo, ph_hi, li, pad; };
enum { I_X = 0, I_C, I_POS, I_WADA, I_BADA, I_WIN, I_GNW, I_WPOOL, I_PSCALE, I_WOUT, I_LN1W, I_LN1B, I_WGRP, I_BGRP, I_WRT, I_BRT, I_W1, I_W3, I_W2, I_LN2W, I_LN2B };

template <class Epi>
__device__ __forceinline__ void naive_gemm(float* lds, const bf16* A, int lda, const float* W, int ldw, int M, int N, int K, const Epi& epi) {
    float* As = lds;
    float* Ws = lds + 16 * 132;
    const int tid = threadIdx.x, tx = tid & 31, ty = tid >> 5;
    const int ntn = N / 128, ntiles = (M / 128) * ntn;
    for (int tile = blockIdx.x; tile < ntiles; tile += gridDim.x) {
        const int tm = tile / ntn, tn = tile % ntn, row0 = tm * 128, col0 = tn * 128;
        float acc[8][4];
#pragma unroll
        for (int i = 0; i < 8; ++i)
#pragma unroll
            for (int j = 0; j < 4; ++j) acc[i][j] = 0.f;
        for (int k0 = 0; k0 < K; k0 += 16) {
            { const int r = tid >> 2, kq = (tid & 3) * 4; const uint2 raw = *(const uint2*)(A + (size_t)(row0 + r) * lda + k0 + kq);
              As[(kq + 0) * 132 + r] = bflo(raw.x); As[(kq + 1) * 132 + r] = bfhi(raw.x); As[(kq + 2) * 132 + r] = bflo(raw.y); As[(kq + 3) * 132 + r] = bfhi(raw.y); }
            { const int k = tid >> 5, n4 = (tid & 31) * 4; *(float4*)(Ws + k * 132 + n4) = *(const float4*)(W + (size_t)(k0 + k) * ldw + col0 + n4); }
            __syncthreads();
#pragma unroll
            for (int k = 0; k < 16; ++k) {
                const float4 a0 = *(const float4*)(As + k * 132 + ty * 8), a1 = *(const float4*)(As + k * 132 + ty * 8 + 4);
                const float4 w = *(const float4*)(Ws + k * 132 + tx * 4);
                const float av[8] = {a0.x, a0.y, a0.z, a0.w, a1.x, a1.y, a1.z, a1.w};
#pragma unroll
                for (int i = 0; i < 8; ++i) { acc[i][0] += av[i] * w.x; acc[i][1] += av[i] * w.y; acc[i][2] += av[i] * w.z; acc[i][3] += av[i] * w.w; }
            }
            __syncthreads();
        }
#pragma unroll
        for (int i = 0; i < 8; ++i) epi(row0 + ty * 8 + i, col0 + tx * 4, make_float4(acc[i][0], acc[i][1], acc[i][2], acc[i][3]));
    }
}

__device__ __forceinline__ void ph_ada_partial(float* lds, const float* c, const float* w_ada, float* part) {
    const int w = blockIdx.x, tid = threadIdx.x;
    if (w >= 96) return;
    const int cb = w % 12, kr = w / 12, c4 = tid & 127, ks = tid >> 7;
    float* cact = lds;
    float4* red = (float4*)(lds + 1024);
    for (int i = tid; i < 1024; i += NTHR) { const int b = i >> 7, kk = i & 127; cact[i] = silu_f(c[b * D + kr * 128 + kk]); }
    __syncthreads();
    float4 acc[8];
#pragma unroll
    for (int b = 0; b < 8; ++b) acc[b] = make_float4(0.f, 0.f, 0.f, 0.f);
    const int col = (cb * 128 + c4) * 4;
    for (int kk = 0; kk < 32; ++kk) {
        const int kl = ks * 32 + kk;
        const float4 wv = *(const float4*)(w_ada + (size_t)(kr * 128 + kl) * ADA + col);
#pragma unroll
        for (int b = 0; b < 8; ++b) { const float a = cact[b * 128 + kl]; acc[b].x += a * wv.x; acc[b].y += a * wv.y; acc[b].z += a * wv.z; acc[b].w += a * wv.w; }
    }
#pragma unroll
    for (int b = 0; b < 8; ++b) red[(ks * 8 + b) * 128 + c4] = acc[b];
    __syncthreads();
    for (int i = tid; i < 1024; i += NTHR) {
        const int b = i >> 7, cc = i & 127;
        float4 s = red[(0 * 8 + b) * 128 + cc];
#pragma unroll
        for (int q = 1; q < 4; ++q) { const float4 v = red[(q * 8 + b) * 128 + cc]; s.x += v.x; s.y += v.y; s.z += v.z; s.w += v.w; }
        *(float4*)(part + ((size_t)kr * 8 + b) * ADA + (cb * 128 + cc) * 4) = s;
    }
}
__device__ __forceinline__ void ph_rot_table(const int* pos, float2* rot) {
    const int gt = blockIdx.x * NTHR + threadIdx.x, GT = gridDim.x * NTHR;
    for (int idx = gt; idx < T * 64; idx += GT) {
        const int t = idx >> 6, i = idx & 63;
        const double inv = exp2(-(double)i * (13.287712379549449 / 64.0));
        const double ang = (double)pos[t] * inv;
        const double k = rint(ang * 0.15915494309189535);
        double r = fma(-k, 6.283185307179586, ang); r = fma(-k, 2.4492935982947064e-16, r);
        const float rf = (float)r;
        rot[idx] = make_float2(cosf(rf), sinf(rf));
    }
}
__device__ __forceinline__ void ph_ada_final_lnmod(float* lds, const float* x, const float* part, const float* b_ada, float* ada, bf16* U) {
    const int w = blockIdx.x, tid = threadIdx.x, lane = tid & 63, wave = tid >> 6, b = w >> 5;
    float* sh1 = lds; float* sc1 = lds + 1024;
    for (int j = tid; j < 2048; j += NTHR) { float s = b_ada[j]; for (int kr = 0; kr < 8; ++kr) s += part[((size_t)kr * 8 + b) * ADA + j]; if (j < 1024) sh1[j] = s; else sc1[j - 1024] = 1.0f + s; }
    { const int j0 = (w & 31) * 192; for (int j = tid; j < 192; j += NTHR) { float s = b_ada[j0 + j]; for (int kr = 0; kr < 8; ++kr) s += part[((size_t)kr * 8 + b) * ADA + j0 + j]; ada[(size_t)b * ADA + j0 + j] = s; } }
    __syncthreads();
    for (int i = 0; i < 8; ++i) {
        const int row = w * 64 + wave * 8 + i;
        const float4* xr = (const float4*)(x + (size_t)row * D) + lane;
        float4 v[4]; float s = 0.f;
#pragma unroll
        for (int j = 0; j < 4; ++j) { v[j] = xr[64 * j]; s += (v[j].x + v[j].y) + (v[j].z + v[j].w); }
        const float mean = wave_sum(s) * (1.f / D); float s2 = 0.f;
#pragma unroll
        for (int j = 0; j < 4; ++j) { v[j].x -= mean; v[j].y -= mean; v[j].z -= mean; v[j].w -= mean; s2 += (v[j].x * v[j].x + v[j].y * v[j].y) + (v[j].z * v[j].z + v[j].w * v[j].w); }
        const float rstd = 1.f / sqrtf(wave_sum(s2) * (1.f / D) + LN_EPS);
        uint2* o = (uint2*)(U + (size_t)row * D) + lane;
#pragma unroll
        for (int j = 0; j < 4; ++j) { const float4 sc = *(const float4*)(sc1 + 4 * lane + 256 * j), sh = *(const float4*)(sh1 + 4 * lane + 256 * j);
            o[64 * j] = make_uint2(pk2(v[j].x * rstd * sc.x + sh.x, v[j].y * rstd * sc.y + sh.y), pk2(v[j].z * rstd * sc.z + sh.z, v[j].w * rstd * sc.w + sh.w)); }
    }
}
__device__ __forceinline__ void ph_ret_naive(float* lds, const bf16* proj, const float2* rot, const float* gnw, bf16* mix) {
    const int w = blockIdx.x, tid = threadIdx.x;
    if (w >= 32) return;
    const int b = w >> 2, h = w & 3, e = tid & 127, dg = tid >> 7;
    const float gamma = 1.0f - exp2f(-5.0f - (float)h);
    float* Q = lds;
    float* Kk = lds + 4096;
    float* V = lds + 8192;
    float* red = lds + 12288;
    float Sx[32];
#pragma unroll
    for (int i = 0; i < 32; ++i) Sx[i] = 0.f;
    for (int t0 = 0; t0 < SEQ; t0 += 32) {
        __syncthreads();
        for (int it = tid; it < 32 * 64; it += NTHR) {
            const int r = it >> 6, i = it & 63; const size_t row = (size_t)b * SEQ + t0 + r;
            const float2 cs = rot[row * 64 + i];
            const bf16* pr = proj + row * INC;
            const float q1 = bf2f(pr[h * 128 + i]), q2 = bf2f(pr[h * 128 + 64 + i]);
            const float k1 = bf2f(pr[512 + h * 128 + i]), k2 = bf2f(pr[512 + h * 128 + 64 + i]);
            Q[r * 128 + i] = q1 * cs.x - q2 * cs.y; Q[r * 128 + 64 + i] = q1 * cs.y + q2 * cs.x;
            Kk[r * 128 + i] = (k1 * cs.x - k2 * cs.y) * 0.08838834764831845f; Kk[r * 128 + 64 + i] = (k1 * cs.y + k2 * cs.x) * 0.08838834764831845f;
            V[r * 128 + i] = bf2f(pr[1024 + h * 128 + i]); V[r * 128 + 64 + i] = bf2f(pr[1024 + h * 128 + 64 + i]);
        }
        __syncthreads();
        for (int r = 0; r < 32; ++r) {
            const float ve = V[r * 128 + e]; float o = 0.f;
#pragma unroll
            for (int dd = 0; dd < 32; ++dd) { const int d = dg * 32 + dd; Sx[dd] = gamma * Sx[dd] + Kk[r * 128 + d] * ve; o += Q[r * 128 + d] * Sx[dd]; }
            red[(r * 4 + dg) * 128 + e] = o;
        }
        __syncthreads();
        { const int lane = tid & 63, wave = tid >> 6;
          for (int rr = 0; rr < 4; ++rr) { const int r = wave * 4 + rr; const size_t row = (size_t)b * SEQ + t0 + r;
              float v0 = 0.f, v1 = 0.f;
#pragma unroll
              for (int q = 0; q < 4; ++q) { v0 += red[(r * 4 + q) * 128 + lane]; v1 += red[(r * 4 + q) * 128 + 64 + lane]; }
              const float mean = wave_sum(v0 + v1) * (1.f / 128.f); v0 -= mean; v1 -= mean;
              const float rstd = 1.f / sqrtf(wave_sum(v0 * v0 + v1 * v1) * (1.f / 128.f) + LN_EPS);
              const bf16* pr = proj + row * INC + 1536 + h * 128;
              const float g0 = bf2f(pr[lane]), g1 = bf2f(pr[64 + lane]);
              bf16* mo = mix + row * D + h * 128;
              mo[lane] = (bf16)f2bf(silu_f(g0) * (v0 * rstd * gnw[h * 128 + lane])); mo[64 + lane] = (bf16)f2bf(silu_f(g1) * (v1 * rstd * gnw[h * 128 + 64 + lane])); } }
    }
}
__device__ __forceinline__ void ph_pool_naive(float* lds, const bf16* proj, const float* w_pool, const float* pscale, bf16* mix) {
    const int tid = threadIdx.x;
    float* P = lds;
    for (int unit = blockIdx.x; unit < 256 * 4; unit += gridDim.x) {
        const int rb = unit >> 2, g = unit & 3, win = 2 << g, row0 = rb * 64;
        __syncthreads();
        for (int it = tid; it < 64 * 128; it += NTHR) {
            const int r = it >> 7, cc = it & 127; const int row = row0 + r, s = row & (SEQ - 1);
            const int cnt = (s + 1 < win) ? (s + 1) : win;
            float sum = 0.f;
            for (int j = 0; j < cnt; ++j) sum += bf2f(proj[(size_t)(row - j) * INC + 2048 + g * 128 + cc]);
            P[it] = sum / (float)cnt - bf2f(proj[(size_t)row * INC + 2048 + g * 128 + cc]);
        }
        __syncthreads();
        const int d = tid & 127, rg = tid >> 7;
        float acc[16];
#pragma unroll
        for (int i = 0; i < 16; ++i) acc[i] = 0.f;
        for (int cc = 0; cc < 128; ++cc) { const float wv = w_pool[((size_t)g * 128 + cc) * 128 + d];
#pragma unroll
            for (int i = 0; i < 16; ++i) acc[i] += P[(rg * 16 + i) * 128 + cc] * wv; }
        const float ps = pscale[g * 128 + d];
#pragma unroll
        for (int i = 0; i < 16; ++i) mix[(size_t)(row0 + rg * 16 + i) * D + 512 + g * 128 + d] = (bf16)f2bf(acc[i] * ps);
    }
}
__device__ __forceinline__ void ph_ln1_ln2mod(float* V1, const float* ln1w, const float* ln1b, const float* ada, bf16* U2) {
    const int tid = threadIdx.x, lane = tid & 63, wave = tid >> 6;
    for (int row = blockIdx.x * 8 + wave; row < T; row += gridDim.x * 8) {
        const int b = row / SEQ;
        float4* xr = (float4*)(V1 + (size_t)row * D) + lane;
        float4 v[4]; float s = 0.f;
#pragma unroll
        for (int j = 0; j < 4; ++j) { v[j] = xr[64 * j]; s += (v[j].x + v[j].y) + (v[j].z + v[j].w); }
        float mean = wave_sum(s) * (1.f / D); float s2 = 0.f;
#pragma unroll
        for (int j = 0; j < 4; ++j) { v[j].x -= mean; v[j].y -= mean; v[j].z -= mean; v[j].w -= mean; s2 += (v[j].x * v[j].x + v[j].y * v[j].y) + (v[j].z * v[j].z + v[j].w * v[j].w); }
        float rstd = 1.f / sqrtf(wave_sum(s2) * (1.f / D) + LN_EPS);
        s = 0.f;
#pragma unroll
        for (int j = 0; j < 4; ++j) { const float4 lw = *((const float4*)ln1w + lane + 64 * j), lb = *((const float4*)ln1b + lane + 64 * j);
            v[j].x = v[j].x * rstd * lw.x + lb.x; v[j].y = v[j].y * rstd * lw.y + lb.y; v[j].z = v[j].z * rstd * lw.z + lb.z; v[j].w = v[j].w * rstd * lw.w + lb.w;
            xr[64 * j] = v[j]; s += (v[j].x + v[j].y) + (v[j].z + v[j].w); }
        mean = wave_sum(s) * (1.f / D); s2 = 0.f;
#pragma unroll
        for (int j = 0; j < 4; ++j) { v[j].x -= mean; v[j].y -= mean; v[j].z -= mean; v[j].w -= mean; s2 += (v[j].x * v[j].x + v[j].y * v[j].y) + (v[j].z * v[j].z + v[j].w * v[j].w); }
        rstd = 1.f / sqrtf(wave_sum(s2) * (1.f / D) + LN_EPS);
        const float* sh2 = ada + (size_t)b * ADA + 3 * D; const float* sc2 = ada + (size_t)b * ADA + 4 * D;
        uint2* o = (uint2*)(U2 + (size_t)row * D) + lane;
#pragma unroll
        for (int j = 0; j < 4; ++j) { const float4 sc = *((const float4*)sc2 + lane + 64 * j), sh = *((const float4*)sh2 + lane + 64 * j);
            o[64 * j] = make_uint2(pk2(v[j].x * rstd * (1.f + sc.x) + sh.x, v[j].y * rstd * (1.f + sc.y) + sh.y), pk2(v[j].z * rstd * (1.f + sc.z) + sh.z, v[j].w * rstd * (1.f + sc.w) + sh.w)); }
    }
}
__device__ __forceinline__ void ph_router_naive(float* lds, const bf16* U2, const float* wg, const float* wr, float* logits) {
    const int tid = threadIdx.x, tl = tid >> 3, jg = tid & 7;
    float* Wl = lds;
    for (int blk = blockIdx.x; blk < T / 64; blk += gridDim.x) {
        const int t = blk * 64 + tl;
        float acc[5] = {0.f, 0.f, 0.f, 0.f, 0.f};
        for (int kh = 0; kh < 2; ++kh) {
            __syncthreads();
            for (int it = tid; it < 512 * 36; it += NTHR) { const int k = it / 36, j = it % 36; Wl[it] = (j < 4) ? wg[(size_t)(kh * 512 + k) * 4 + j] : wr[(size_t)(kh * 512 + k) * 32 + (j - 4)]; }
            __syncthreads();
            for (int k = 0; k < 512; ++k) { const float u = bf2f(U2[(size_t)t * D + kh * 512 + k]);
#pragma unroll
                for (int i = 0; i < 5; ++i) { const int j = jg + 8 * i; if (j < 36) acc[i] += u * Wl[k * 36 + j]; } }
        }
#pragma unroll
        for (int i = 0; i < 5; ++i) { const int j = jg + 8 * i; if (j < 36) logits[(size_t)t * 64 + j] = acc[i]; }
    }
}
__device__ __forceinline__ void ph_route(const float* logits, int npart, const float* bg, const float* br, int* tok_e, float* tok_w) {
    const int gt = blockIdx.x * NTHR + threadIdx.x, GT = gridDim.x * NTHR;
    for (int t = gt; t < T; t += GT) {
        float gl[4];
#pragma unroll
        for (int j = 0; j < 4; ++j) { float s = bg[j]; for (int p = 0; p < npart; ++p) s += logits[((size_t)p * T + t) * 64 + j]; gl[j] = s; }
        int gi = 0; float gm = gl[0];
#pragma unroll
        for (int j = 1; j < 4; ++j) if (gl[j] > gm) { gm = gl[j]; gi = j; }
        float den = 0.f;
#pragma unroll
        for (int j = 0; j < 4; ++j) den += expf(gl[j] - gm);
        const float gprob = 1.0f / den;
        float el[8];
#pragma unroll
        for (int i = 0; i < 8; ++i) { float s = 0.f; for (int p = 0; p < npart; ++p) s += logits[((size_t)p * T + t) * 64 + 4 + gi * 8 + i]; el[i] = s + br[gi * 8 + i]; }
        int i0 = 0; float v0 = el[0];
#pragma unroll
        for (int i = 1; i < 8; ++i) if (el[i] > v0) { v0 = el[i]; i0 = i; }
        int i1 = -1; float v1 = 0.f;
#pragma unroll
        for (int i = 0; i < 8; ++i) if (i != i0 && (i1 < 0 || el[i] > v1)) { v1 = el[i]; i1 = i; }
        const float ex = expf(v1 - v0), inv = 1.0f / (1.0f + ex);
        tok_e[2 * t] = gi * 8 + i0; tok_e[2 * t + 1] = gi * 8 + i1;
        tok_w[2 * t] = gprob * inv; tok_w[2 * t + 1] = gprob * ex * inv;
    }
}
__device__ __forceinline__ void ph_moe_naive(float* lds, const bf16* U2, const int* tok_e, const float* tok_w, const float* w1, const float* w3, const float* w2, float* Y2) {
    const int tid = threadIdx.x;
    float* u = lds;
    float* pa = lds + 1024;
    float* pb = lds + 1536;
    float* hh = lds + 2048;
    for (int t = blockIdx.x; t < T; t += gridDim.x) {
        __syncthreads();
        for (int i = tid; i < D; i += NTHR) u[i] = bf2f(U2[(size_t)t * D + i]);
        float y0 = 0.f, y1 = 0.f;
        for (int k = 0; k < 2; ++k) {
            const int e = tok_e[2 * t + k]; const float wgt = tok_w[2 * t + k];
            __syncthreads();
            { const int f = tid & 255, hf = tid >> 8; const float* p1 = w1 + ((size_t)e * D + hf * 512) * DE + f; const float* p3 = w3 + ((size_t)e * D + hf * 512) * DE + f;
              float a = 0.f, bq = 0.f;
              for (int d = 0; d < 512; ++d) { const float uv = u[hf * 512 + d]; a += uv * p1[(size_t)d * DE]; bq += uv * p3[(size_t)d * DE]; }
              pa[hf * 256 + f] = a; pb[hf * 256 + f] = bq; }
            __syncthreads();
            if (tid < 256) { const float a = pa[tid] + pa[256 + tid], bq = pb[tid] + pb[256 + tid]; hh[tid] = silu_f(a) * bq * wgt; }
            __syncthreads();
            { const float* p2 = w2 + (size_t)e * DE * D + tid;
              for (int f = 0; f < 256; ++f) { const float hv = hh[f]; y0 += hv * p2[(size_t)f * D]; y1 += hv * p2[(size_t)f * D + 512]; } }
        }
        Y2[(size_t)t * D + tid] = y0; Y2[(size_t)t * D + 512 + tid] = y1;
    }
}
__device__ __forceinline__ void ph_final(const float* X1, const float* Y2, const float* ada, const float* ln2w, const float* ln2b, float* out) {
    const int tid = threadIdx.x, lane = tid & 63, wave = tid >> 6;
    for (int row = blockIdx.x * 8 + wave; row < T; row += gridDim.x * 8) {
        const int b = row / SEQ;
        const float4* xr = (const float4*)(X1 + (size_t)row * D) + lane; const float4* yr = (const float4*)(Y2 + (size_t)row * D) + lane;
        const float4* g2 = (const float4*)(ada + (size_t)b * ADA + 5 * D) + lane;
        float4 v[4]; float s = 0.f;
#pragma unroll
        for (int j = 0; j < 4; ++j) { const float4 xv = xr[64 * j], yv = yr[64 * j], gv = g2[64 * j];
            v[j].x = ALPHA * xv.x + gv.x * yv.x; v[j].y = ALPHA * xv.y + gv.y * yv.y; v[j].z = ALPHA * xv.z + gv.z * yv.z; v[j].w = ALPHA * xv.w + gv.w * yv.w; s += (v[j].x + v[j].y) + (v[j].z + v[j].w); }
        const float mean = wave_sum(s) * (1.f / D); float s2 = 0.f;
#pragma unroll
        for (int j = 0; j < 4; ++j) { v[j].x -= mean; v[j].y -= mean; v[j].z -= mean; v[j].w -= mean; s2 += (v[j].x * v[j].x + v[j].y * v[j].y) + (v[j].z * v[j].z + v[j].w * v[j].w); }
        const float rstd = 1.f / sqrtf(wave_sum(s2) * (1.f / D) + LN_EPS);
        float4* o = (float4*)(out + (size_t)row * D) + lane;
#pragma unroll
        for (int j = 0; j < 4; ++j) { const float4 lw = *((const float4*)ln2w + lane + 64 * j), lb = *((const float4*)ln2b + lane + 64 * j);
            o[64 * j] = make_float4(v[j].x * rstd * lw.x + lb.x, v[j].y * rstd * lw.y + lb.y, v[j].z * rstd * lw.z + lb.z, v[j].w * rstd * lw.w + lb.w); }
    }
}

struct EpiStoreBf16 { bf16* O; int ldc; __device__ __forceinline__ void operator()(int row, int col, float4 a) const { *(uint2*)(O + (size_t)row * ldc + col) = make_uint2(pk2(a.x, a.y), pk2(a.z, a.w)); } };
struct EpiV1 { const float* x; const float* ada; float* V1;
    __device__ __forceinline__ void operator()(int row, int col, float4 a) const { const int b = row / SEQ; const float4 xv = *(const float4*)(x + (size_t)row * D + col), g = *(const float4*)(ada + (size_t)b * ADA + 2 * D + col);
        *(float4*)(V1 + (size_t)row * D + col) = make_float4(ALPHA * xv.x + g.x * a.x, ALPHA * xv.y + g.y * a.y, ALPHA * xv.z + g.z * a.z, ALPHA * xv.w + g.w * a.w); } };


namespace pg8 {
#define PG8_LAS __attribute__((address_space(3)))
typedef unsigned short bf16_t;
typedef short bf16x8 __attribute__((ext_vector_type(8)));
typedef float f32x4 __attribute__((ext_vector_type(4)));
typedef unsigned u32x4 __attribute__((ext_vector_type(4)));
constexpr int BM = 256, BK = 64, HALF = 128, HTB = HALF * BK * 2  , STAGE_BYTES = 8 * HTB, NXCD = 8, WGM = 8;

__host__ __device__ __forceinline__ int lds_byte(int r, int c) { const int st = (r >> 4) * 2 + (c >> 5), rr = r & 15, cc = c & 31, ob = rr * 64 + cc * 2; return st * 1024 + (ob ^ (((ob >> 9) & 1) << 5)); }
__host__ __device__ __forceinline__ void stage_rc(int b, int& R, int& C) { const int st = b / 1024, sb = b % 1024, swz = sb ^ (((sb >> 9) & 1) << 5); R = (st >> 1) * 16 + swz / 64; C = (st & 1) * 32 + (swz % 64) / 2; }
__host__ __device__ __forceinline__ int perm32(int rho) { const int n = rho >> 4, i = rho & 15; return 8 * (i >> 2) + 4 * n + (i & 3); }

struct Unit { int pm, pn, ka; };
struct Gemm { const bf16_t* A; const bf16_t* Bt; int M, N, K, lda, ldb; };

struct StaticOrder {
    int nM, nN, nwg, G, c;
    __host__ __device__ void init(int M, int N, int G_, int c_) { nM = M / BM; nN = N / BM; nwg = nM * nN; G = G_; c = c_; }
    __host__ __device__ bool next(int i, Unit& u) const {
        const long L = (long)i * G + c; if (L >= nwg) return false;
        int wgid = (int)L; { const int q = nwg / NXCD, r = nwg % NXCD, xcd = wgid % NXCD, off = wgid / NXCD; wgid = (xcd < r ? xcd * (q + 1) : r * (q + 1) + (xcd - r) * q) + off; }
        const int nig = WGM * nN, gid = wgid / nig, fm = gid * WGM, gsz = (nM - fm) < WGM ? (nM - fm) : WGM;
        u.pm = fm + ((wgid % nig) % gsz); u.pn = (wgid % nig) / gsz; u.ka = 0; return true;
    }
    __device__ __forceinline__ void a_ready(const Unit&) const {}
    __device__ __forceinline__ void done(const Unit&) const {}
};

__device__ __forceinline__ unsigned cvt_pk_bf16(float lo, float hi) { unsigned r; asm volatile("v_cvt_pk_bf16_f32 %0, %1, %2" : "=v"(r) : "v"(lo), "v"(hi)); return r; }
typedef float f32x2 __attribute__((ext_vector_type(2)));
__device__ __forceinline__ f32x2 gelu_pk(f32x2 v) { return v; }
template <int ACT  > struct EpiBf16 {
    static constexpr bool PERM = true, AFTER_DRAIN = false; static_assert(ACT == 0 || ACT == 1, "EpiBf16: ACT is 0 (none) or 1 (gelu_pk)");
    bf16_t* O; int ldc; const float* bias; int split_cols; size_t split_stride; float scale0;
    __device__ __forceinline__ void operator()(const f32x4 (&acc)[2][2][4][2], const Unit& u, int wr, int wc, int fr, int fq) const {
        const int row0 = u.pm * BM + wr * 64 + fr; int colt = u.pn * BM; bf16_t* base = O;
        float sc = 1.f; if (split_cols) { const int t = colt / split_cols; base += (size_t)t * split_stride; colt -= t * split_cols; if (t == 0) sc = scale0; }
        const int col0 = colt + wc * 32 + 8 * fq, bcol0 = u.pn * BM + wc * 32 + 8 * fq;
        f32x4 bv[2][2];
#pragma unroll
        for (int bj = 0; bj < 2; ++bj)
#pragma unroll
            for (int n = 0; n < 2; ++n) bv[bj][n] = bias ? *(const f32x4*)(bias + bcol0 + bj * HALF + 4 * n) : (f32x4){0.f, 0.f, 0.f, 0.f};
#pragma unroll
        for (int ai = 0; ai < 2; ++ai)
#pragma unroll
            for (int m = 0; m < 4; ++m) { bf16_t* rowp = base + (size_t)(row0 + ai * HALF + m * 16) * ldc + col0;
#pragma unroll
                for (int bj = 0; bj < 2; ++bj) { f32x4 v0 = acc[ai][bj][m][0] + bv[bj][0], v1 = acc[ai][bj][m][1] + bv[bj][1];
                    if (ACT == 1) { f32x2 a = gelu_pk((f32x2){v0[0], v0[1]}), b = gelu_pk((f32x2){v0[2], v0[3]}), c = gelu_pk((f32x2){v1[0], v1[1]}), d = gelu_pk((f32x2){v1[2], v1[3]});
                        v0 = (f32x4){a.x, a.y, b.x, b.y}; v1 = (f32x4){c.x, c.y, d.x, d.y}; }
                    v0 = v0 * sc; v1 = v1 * sc; u32x4 w; w.x = cvt_pk_bf16(v0[0], v0[1]); w.y = cvt_pk_bf16(v0[2], v0[3]); w.z = cvt_pk_bf16(v1[0], v1[1]); w.w = cvt_pk_bf16(v1[2], v1[3]);
                    *(u32x4*)(rowp + bj * HALF) = w; } }
    }
};

struct EpiV1f {
    static constexpr bool PERM = false, AFTER_DRAIN = false;
    const float* x; const float* ada; float* V1;
    __device__ __forceinline__ void operator()(const f32x4 (&acc)[2][2][4][2], const Unit& u, int wr, int wc, int fr, int fq) const {
        const int row0 = u.pm * BM + wr * 64 + fr, col0 = u.pn * BM + wc * 32 + 4 * fq; const int b = (u.pm * BM) / 2048;
        f32x4 gv[2][2];
#pragma unroll
        for (int bj = 0; bj < 2; ++bj)
#pragma unroll
            for (int n = 0; n < 2; ++n) gv[bj][n] = *(const f32x4*)(ada + (size_t)b * 6144 + 2048 + col0 + bj * HALF + n * 16);
#pragma unroll
        for (int ai = 0; ai < 2; ++ai)
#pragma unroll
            for (int m = 0; m < 4; ++m) { const size_t off = (size_t)(row0 + ai * HALF + m * 16) * 1024 + col0;
#pragma unroll
                for (int bj = 0; bj < 2; ++bj)
#pragma unroll
                    for (int n = 0; n < 2; ++n) { const f32x4 xv = *(const f32x4*)(x + off + bj * HALF + n * 16);
                        *(f32x4*)(V1 + off + bj * HALF + n * 16) = xv * 1.189207115002721f + gv[bj][n] * acc[ai][bj][m][n]; } }
    }
};

template <class Epi, class Sched, bool ALIGN_EPI = false, bool SP2 = false>
__device__ __forceinline__ void gemm_phase(PG8_LAS unsigned char* lds, const Gemm g, const Sched& S, const Epi& E) {
    const int tid = threadIdx.x, wid = __builtin_amdgcn_readfirstlane(tid >> 6), lane = tid & 63, wr = wid >> 2, wc = wid & 3, fr = lane & 15, fq = lane >> 4;
    const int K = g.K, nt = K / BK;
    unsigned voffA[2], voffB[2];
#pragma unroll
    for (int i = 0; i < 2; ++i) { int R, C; stage_rc(tid * 16 + i * 8192, R, C); const int Rb = Epi::PERM ? ((R & ~31) + perm32(R & 31)) : R;
        voffA[i] = (unsigned)(R * g.lda + C) * 2u; voffB[i] = (unsigned)(Rb * g.ldb + C) * 2u; }
    const size_t kstep = (size_t)(BK * 2);
    const size_t hstepA = (size_t)HALF * g.lda * 2, hstepB = (size_t)HALF * g.ldb * 2;
    const size_t tstepA = 2 * hstepA, tstepB = 2 * hstepB;
    const unsigned ldsw = (unsigned)wid * 1024u;
    const int aoff = lds_byte(wr * 64 + fr, fq * 8), boff = lds_byte(wc * 32 + fr, fq * 8);
#define PG8_SA(b, h) (((b) * 2 + (h)) * HTB)
#define PG8_SB(b, h) ((4 + (b) * 2 + (h)) * HTB)
#define PG8_STAGE(bufoff, gbase, voff) do { _Pragma("unroll") for (int _i = 0; _i < 2; ++_i) \
        __builtin_amdgcn_global_load_lds((const unsigned*)((const char*)(gbase) + (voff)[_i]), (PG8_LAS unsigned*)(lds + (bufoff) + ldsw + _i * 8192), 16, 0, 0); } while (0)
#define PG8_LDA(dst, b, h) do { _Pragma("unroll") for (int m = 0; m < 4; ++m) _Pragma("unroll") for (int k = 0; k < 2; ++k) dst[m][k] = *(const PG8_LAS bf16x8*)(lds + PG8_SA(b, h) + aoff + m * 2048 + k * 1024); } while (0)
#define PG8_LDB(dst, b, h) do { _Pragma("unroll") for (int n = 0; n < 2; ++n) _Pragma("unroll") for (int k = 0; k < 2; ++k) dst[n][k] = *(const PG8_LAS bf16x8*)(lds + PG8_SB(b, h) + boff + n * 2048 + k * 1024); } while (0)
#define PG8_MMA(ai, bj, At, Bt) do { __builtin_amdgcn_s_setprio(1); _Pragma("unroll") for (int m = 0; m < 4; ++m) _Pragma("unroll") for (int n = 0; n < 2; ++n) _Pragma("unroll") for (int k = 0; k < 2; ++k) \
        acc[ai][bj][m][n] = __builtin_amdgcn_mfma_f32_16x16x32_bf16(Bt[n][k], At[m][k], acc[ai][bj][m][n], 0, 0, 0); __builtin_amdgcn_s_setprio(0); } while (0)
#define PG8_WAIT_V(n) asm volatile("s_waitcnt vmcnt(" #n ")" ::: "memory")
#define PG8_WAIT_L(n) asm volatile("s_waitcnt lgkmcnt(" #n ")" ::: "memory")
#define PG8_BAR __builtin_amdgcn_s_barrier()
#define PG8_SCHED __builtin_amdgcn_sched_barrier(0)
    Unit cur, nxt; int ui = 0;
    if (!S.next(0, cur)) return;
    f32x4 acc[2][2][4][2];
#pragma unroll
    for (int a = 0; a < 2; ++a)
#pragma unroll
        for (int b = 0; b < 2; ++b)
#pragma unroll
            for (int m = 0; m < 4; ++m)
#pragma unroll
                for (int n = 0; n < 2; ++n) acc[a][b][m][n] = (f32x4){0.f, 0.f, 0.f, 0.f};
    bf16x8 At[4][2], B0[2][2], B1[2][2];
    const char* cA = (const char*)g.A + (size_t)cur.pm * tstepA + (size_t)cur.ka * 2; const char* cB = (const char*)g.Bt + (size_t)cur.pn * tstepB + (size_t)cur.ka * 2;
    S.a_ready(cur);
    if constexpr (SP2) {
        PG8_STAGE(PG8_SB(0, 0), cB, voffB); PG8_STAGE(PG8_SB(0, 1), cB + hstepB, voffB); PG8_STAGE(PG8_SA(0, 0), cA, voffA); PG8_STAGE(PG8_SA(0, 1), cA + hstepA, voffA);
        if (wr == 1) PG8_BAR;
        PG8_WAIT_V(2); PG8_BAR;
        PG8_STAGE(PG8_SB(1, 0), cB + kstep, voffB); PG8_STAGE(PG8_SA(1, 0), cA + kstep, voffA); PG8_STAGE(PG8_SB(1, 1), cB + hstepB + kstep, voffB);
        PG8_WAIT_V(6); PG8_BAR;
    } else {
        PG8_STAGE(PG8_SB(0, 0), cB, voffB); PG8_STAGE(PG8_SA(0, 0), cA, voffA); PG8_STAGE(PG8_SB(0, 1), cB + hstepB, voffB); PG8_STAGE(PG8_SA(0, 1), cA + hstepA, voffA);
        if (wr == 1) PG8_BAR;
        PG8_WAIT_V(4); PG8_BAR;
        PG8_STAGE(PG8_SB(1, 0), cB + kstep, voffB); PG8_STAGE(PG8_SA(1, 0), cA + kstep, voffA); PG8_STAGE(PG8_SB(1, 1), cB + hstepB + kstep, voffB);
        PG8_WAIT_V(6); PG8_BAR;
    }
    for (;;) {
        const bool has_next = S.next(ui + 1, nxt);
        const char* nA = has_next ? (const char*)g.A + (size_t)nxt.pm * tstepA + (size_t)nxt.ka * 2 : cA; const char* nB = has_next ? (const char*)g.Bt + (size_t)nxt.pn * tstepB + (size_t)nxt.ka * 2 : cB;
        for (int t = 0; t < nt; t += 2) {
            const bool last = (t == nt - 2);
            const char* a1 = cA + (size_t)(t + 1) * kstep;
            const char* a2 = last ? nA : cA + (size_t)(t + 2) * kstep; const char* b2 = last ? nB : cB + (size_t)(t + 2) * kstep;
            const char* a3 = a2 + kstep; const char* b3 = b2 + kstep;
            if (last && has_next) S.a_ready(nxt);
            if constexpr (SP2) {
            PG8_LDB(B0, 0, 0); PG8_LDB(B1, 0, 1); PG8_SCHED; PG8_LDA(At, 0, 0); PG8_STAGE(PG8_SA(1, 1), a1 + hstepA, voffA);
            PG8_WAIT_V(8); PG8_WAIT_L(0); PG8_BAR; PG8_MMA(0, 0, At, B0); PG8_MMA(0, 1, At, B1); PG8_BAR; PG8_SCHED;
            PG8_LDA(At, 0, 1); PG8_STAGE(PG8_SB(0, 0), b2, voffB); PG8_STAGE(PG8_SB(0, 1), b2 + hstepB, voffB); PG8_STAGE(PG8_SA(0, 0), a2, voffA);
            PG8_WAIT_V(8); PG8_WAIT_L(0); PG8_BAR; PG8_MMA(1, 0, At, B0); PG8_MMA(1, 1, At, B1); PG8_BAR; PG8_SCHED;
            PG8_LDB(B0, 1, 0); PG8_LDB(B1, 1, 1); PG8_SCHED; PG8_LDA(At, 1, 0); PG8_STAGE(PG8_SA(0, 1), a2 + hstepA, voffA);
            PG8_WAIT_V(8); PG8_WAIT_L(0); PG8_BAR; PG8_MMA(0, 0, At, B0); PG8_MMA(0, 1, At, B1); PG8_BAR; PG8_SCHED;
            PG8_LDA(At, 1, 1); PG8_STAGE(PG8_SB(1, 0), b3, voffB); PG8_STAGE(PG8_SB(1, 1), b3 + hstepB, voffB); PG8_STAGE(PG8_SA(1, 0), a3, voffA);
            PG8_WAIT_V(8); PG8_WAIT_L(0); PG8_BAR; PG8_MMA(1, 0, At, B0); PG8_MMA(1, 1, At, B1); PG8_BAR; PG8_SCHED;
            } else {
            PG8_LDB(B0, 0, 0); PG8_SCHED; PG8_LDA(At, 0, 0); PG8_STAGE(PG8_SA(1, 1), a1 + hstepA, voffA);
            PG8_WAIT_L(8); PG8_BAR; PG8_WAIT_L(0); PG8_MMA(0, 0, At, B0); PG8_BAR; PG8_SCHED;
            PG8_LDB(B1, 0, 1); PG8_STAGE(PG8_SB(0, 0), b2, voffB);
            PG8_BAR; PG8_WAIT_L(0); PG8_MMA(0, 1, At, B1); PG8_BAR;
            PG8_LDA(At, 0, 1); PG8_STAGE(PG8_SA(0, 0), a2, voffA);
            PG8_BAR; PG8_WAIT_L(0); PG8_MMA(1, 0, At, B0); PG8_BAR; PG8_SCHED;
            PG8_STAGE(PG8_SB(0, 1), b2 + hstepB, voffB);
            PG8_WAIT_V(6); PG8_BAR; PG8_MMA(1, 1, At, B1); PG8_BAR;
            PG8_LDB(B0, 1, 0); PG8_SCHED; PG8_LDA(At, 1, 0); PG8_STAGE(PG8_SA(0, 1), a2 + hstepA, voffA);
            PG8_WAIT_L(8); PG8_BAR; PG8_WAIT_L(0); PG8_MMA(0, 0, At, B0); PG8_BAR; PG8_SCHED;
            PG8_LDB(B1, 1, 1); PG8_STAGE(PG8_SB(1, 0), b3, voffB);
            PG8_BAR; PG8_WAIT_L(0); PG8_MMA(0, 1, At, B1); PG8_BAR;
            PG8_LDA(At, 1, 1); PG8_STAGE(PG8_SA(1, 0), a3, voffA);
            PG8_BAR; PG8_WAIT_L(0); PG8_MMA(1, 0, At, B0); PG8_BAR; PG8_SCHED;
            PG8_STAGE(PG8_SB(1, 1), b3 + hstepB, voffB);
            PG8_WAIT_V(6); PG8_BAR; PG8_MMA(1, 1, At, B1); PG8_BAR;
            }
        }
        if constexpr (ALIGN_EPI) { if (wr == 0) PG8_BAR; }
        if constexpr (!Epi::AFTER_DRAIN) { E(acc, cur, wr, wc, fr, fq); S.done(cur); }
        if (!has_next) break;
#pragma unroll
        for (int a = 0; a < 2; ++a)
#pragma unroll
            for (int b = 0; b < 2; ++b)
#pragma unroll
                for (int m = 0; m < 4; ++m)
#pragma unroll
                    for (int n = 0; n < 2; ++n) acc[a][b][m][n] = (f32x4){0.f, 0.f, 0.f, 0.f};
        cur = nxt; cA = nA; cB = nB; ++ui;
        if constexpr (ALIGN_EPI) { if (wr == 1) PG8_BAR; }
    }
    PG8_WAIT_V(0);
    if constexpr (!ALIGN_EPI) { if (wr == 0) PG8_BAR; }
    PG8_BAR;
    if constexpr (Epi::AFTER_DRAIN) { E.fused(acc, cur, wr, wc, fr, fq, lds, wid, lane); S.done(cur); }
#undef PG8_SA
#undef PG8_SB
#undef PG8_STAGE
#undef PG8_LDA
#undef PG8_LDB
#undef PG8_MMA
#undef PG8_WAIT_V
#undef PG8_WAIT_L
#undef PG8_BAR
#undef PG8_SCHED
}
}

__device__ __forceinline__ void p0_transpose_item(const float* W, int K, int N, bf16* WT, int row_off, float* scr, int item, int lane) {
    const int nblk = N / 32, kb = item / nblk, nb = item % nblk, k0 = 64 * kb, n0 = 32 * nb;
#pragma unroll 8
    for (int i = 0; i < 32; ++i) { const int kk = 2 * i + (lane >> 5); scr[kk * 33 + (lane & 31)] = W[(size_t)(k0 + kk) * N + n0 + (lane & 31)]; }
    asm volatile("s_waitcnt lgkmcnt(0)" ::: "memory");
    const int c = lane & 7;
#pragma unroll
    for (int j = 0; j < 4; ++j) { const int n = (lane >> 3) + 8 * j; const float* s = scr + (8 * c) * 33 + n;
        uint4 o; o.x = pk2(s[0 * 33], s[1 * 33]); o.y = pk2(s[2 * 33], s[3 * 33]); o.z = pk2(s[4 * 33], s[5 * 33]); o.w = pk2(s[6 * 33], s[7 * 33]);
        *(uint4*)(WT + (size_t)(row_off + n0 + n) * K + k0 + 8 * c) = o; }
    asm volatile("s_waitcnt lgkmcnt(0)" ::: "memory");
}
__device__ __forceinline__ void ph_convert(float* lds, const Args& a, bf16* Win_t, bf16* Wout_t, bf16* W13_t, bf16* W2_t, bf16* Wpool_t, bf16* Wr_t) {
    const int tid = threadIdx.x, lane = tid & 63, wave = tid >> 6;
    float* scr = lds + wave * (64 * 33);
    const int gw = blockIdx.x * 8 + wave, NGW = gridDim.x * 8;
    constexpr int I_IN = 16 * 80, I_OUT = 16 * 32, I_E13 = 16 * 8, I_E2 = 4 * 32, I_PL = 2 * 4;
    constexpr int NITEMS = I_IN + I_OUT + NE * 2 * I_E13 + NE * I_E2 + 4 * I_PL;
    for (int it = gw; it < NITEMS; it += NGW) {
        int r = it;
        if (r < I_IN) { p0_transpose_item((const float*)a.in[I_WIN], D, INC, Win_t, 0, scr, r, lane); continue; } r -= I_IN;
        if (r < I_OUT) { p0_transpose_item((const float*)a.in[I_WOUT], D, D, Wout_t, 0, scr, r, lane); continue; } r -= I_OUT;
        if (r < NE * 2 * I_E13) { const int e = r / (2 * I_E13), q = r % (2 * I_E13), is3 = q / I_E13, item = q % I_E13; const int h = (item % 8) / 4;
            const float* W = (const float*)a.in[is3 ? I_W3 : I_W1] + (size_t)e * D * DE;
            p0_transpose_item(W, D, DE, W13_t, e * 512 + h * 128 + is3 * 128, scr, item, lane); continue; } r -= NE * 2 * I_E13;
        if (r < NE * I_E2) { const int e = r / I_E2, item = r % I_E2; p0_transpose_item((const float*)a.in[I_W2] + (size_t)e * DE * D, DE, D, W2_t, e * 1024, scr, item, lane); continue; } r -= NE * I_E2;
        { const int g = r / I_PL, item = r % I_PL; p0_transpose_item((const float*)a.in[I_WPOOL] + (size_t)g * 128 * 128, 128, 128, Wpool_t, g * 128, scr, item, lane); }
    }
    { const float* wg = (const float*)a.in[I_WGRP]; const float* wr = (const float*)a.in[I_WRT];
      for (int it = blockIdx.x * NTHR + tid; it < 256 * 128; it += gridDim.x * NTHR) { const int j = it >> 7, k0 = (it & 127) * 8; float v[8];
#pragma unroll
          for (int q = 0; q < 8; ++q) v[q] = (j < 4) ? wg[(size_t)(k0 + q) * 4 + j] : (j < 36 ? wr[(size_t)(k0 + q) * 32 + (j - 4)] : 0.f);
          *(uint4*)(Wr_t + (size_t)j * D + k0) = make_uint4(pk2(v[0], v[1]), pk2(v[2], v[3]), pk2(v[4], v[5]), pk2(v[6], v[7])); } }
}

#define LAS __attribute__((address_space(3)))
#define XB_TMO      128
#define XB_XCNT(j)  (256  + 64 * (j))
#define XB_XSUB(j)  (1280 + 64 * (j))
#define XB_XGEN(j)  (2304 + 64 * (j))
#define XB_TOP      3328
#define XB_TOPGEN   3392
#define XCD_BAR_WORDS 3456
#define XB_SPIN_CAP (1u << 22)
__device__ __forceinline__ unsigned xb_ld(unsigned* p)              { return __hip_atomic_load(p, __ATOMIC_RELAXED, __HIP_MEMORY_SCOPE_AGENT); }
__device__ __forceinline__ unsigned xb_add(unsigned* p, unsigned v) { return __hip_atomic_fetch_add(p, v, __ATOMIC_RELAXED, __HIP_MEMORY_SCOPE_AGENT); }
__device__ __forceinline__ unsigned xb_xcc_id() { return (unsigned)__builtin_amdgcn_s_getreg((3 << 11) | 20) & 0xFu; }
#define XB_SPIN(cond, bar) do { unsigned _sp = 0; while (cond) { __builtin_amdgcn_s_sleep(1); \
    if ((++_sp & 255u) == 0u) { if (xb_ld(&(bar)[XB_TMO])) break; if (_sp > XB_SPIN_CAP) { atomicAdd(&(bar)[XB_TMO], 1u); break; } } } } while (0)
struct XcdBarrier { unsigned* bar; unsigned x; volatile LAS unsigned* st; };
__device__ __forceinline__ XcdBarrier xcd_barrier_post(unsigned* bar, volatile LAS unsigned* st) {
    XcdBarrier b; b.bar = bar; b.x = xb_xcc_id(); b.st = st;
    if (threadIdx.x == 0) (void)xb_add(&bar[XB_XCNT(b.x)], 1u);
    return b;
}
__device__ __forceinline__ void xcd_barrier_complete(unsigned* bar, unsigned x, unsigned& nloc, unsigned& nx) {
    const unsigned G = gridDim.x * gridDim.y * gridDim.z;
    unsigned sum, cnt, mine, sp = 0u;
    for (;;) {
        sum = 0u; cnt = 0u; mine = 0u;
#pragma unroll
        for (unsigned j = 0; j < 16; ++j) { const unsigned c = xb_ld(&bar[XB_XCNT(j)]); sum += c; cnt += (c > 0u) ? 1u : 0u; mine = (j == x) ? c : mine; }
        if (sum == G) break;
        __builtin_amdgcn_s_sleep(1);
        if ((++sp & 255u) == 0u) { if (xb_ld(&bar[XB_TMO])) break; if (sp > XB_SPIN_CAP) { atomicAdd(&bar[XB_TMO], 1u); break; } }
    }
    nloc = mine > 0u ? mine : 1u; nx = cnt > 0u ? cnt : 1u;
}
__device__ __forceinline__ void xcd_barrier(const XcdBarrier& b) {
    asm volatile("s_waitcnt vmcnt(0)" ::: "memory");
    __syncthreads();
    if (threadIdx.x == 0) {
        unsigned* bar = b.bar;
        __builtin_amdgcn_s_waitcnt(0);
        unsigned nloc = b.st[0], nx = b.st[1];
        if (nloc == 0u) { xcd_barrier_complete(bar, b.x, nloc, nx); b.st[0] = nloc; b.st[1] = nx; }
        const unsigned old = xb_add(&bar[XB_XSUB(b.x)], 1u);
        const unsigned gen = old / nloc;
        if (old + 1u == (gen + 1u) * nloc) {
            __builtin_amdgcn_fence(__ATOMIC_RELEASE, "agent");
            asm volatile("s_waitcnt vmcnt(0)" ::: "memory");
            const unsigned og = xb_add(&bar[XB_TOP], 1u);
            const unsigned tg = og / nx;
            if (og + 1u == (tg + 1u) * nx) xb_add(&bar[XB_TOPGEN], 1u);
            else XB_SPIN(xb_ld(&bar[XB_TOPGEN]) == tg, bar);
            __builtin_amdgcn_fence(__ATOMIC_ACQUIRE, "agent");
            xb_add(&bar[XB_XGEN(b.x)], 1u);
            asm volatile("s_waitcnt vmcnt(0)" ::: "memory");
        } else {
            XB_SPIN(xb_ld(&bar[XB_XGEN(b.x)]) == gen, bar);
            __builtin_amdgcn_fence(__ATOMIC_ACQUIRE, "agent");
            asm volatile("s_waitcnt vmcnt(0)" ::: "memory");
        }
    }
    __syncthreads();
}
constexpr int CW_BAR = 1024;

constexpr int LDS_BYTES = 147456;
constexpr int MISC_OFF = LDS_BYTES - 64;
constexpr int N_PHASES = 11;

__global__ void __launch_bounds__(NTHR, 2) mk_fwd(Args args) {
    extern __shared__ __attribute__((aligned(16))) unsigned char lds_raw[];
    float* lds = (float*)lds_raw;
    unsigned char* ws = args.ws;
    const float* x = (const float*)args.in[I_X];
    float* part = (float*)(ws + WS_ADAP); float* ada = (float*)(ws + WS_ADA);
    int* tok_e = (int*)(ws + WS_TOKE); float* tok_w = (float*)(ws + WS_TOKW);
    float2* rot = (float2*)(ws + WS_ROT);
    bf16* U = (bf16*)(ws + WS_U); bf16* PROJ = (bf16*)(ws + WS_PROJ); float* V1 = (float*)(ws + WS_V1);
    float* LOG = (float*)(ws + WS_LOG); bf16* MIX = (bf16*)(ws + WS_MIX); float* Y2 = (float*)(ws + WS_Y2);
    const int lo = args.ph_lo, hi = args.ph_hi;
    volatile LAS unsigned* MISC = (volatile LAS unsigned*)((LAS unsigned char*)lds_raw + MISC_OFF);
    if (threadIdx.x < 16) MISC[threadIdx.x] = 0u;
    __syncthreads();
    XcdBarrier bar; bar.bar = (unsigned*)(ws + WS_CTL) + CW_BAR; bar.x = 0; bar.st = nullptr;
    if (hi - lo > 1) bar = xcd_barrier_post((unsigned*)(ws + WS_CTL) + CW_BAR, MISC);
#define IN(k) (lo <= (k) && (k) < hi)
#define SEAM(k) do { if (IN(k) && IN((k) + 1)) xcd_barrier(bar); } while (0)
    if (IN(0)) { ph_ada_partial(lds, (const float*)args.in[I_C], (const float*)args.in[I_WADA], part); __syncthreads(); ph_rot_table((const int*)args.in[I_POS], rot);
        ph_convert(lds, args, (bf16*)(ws + WS_WIN), (bf16*)(ws + WS_WOUT), (bf16*)(ws + WS_W13), (bf16*)(ws + WS_W2), (bf16*)(ws + WS_WPOOL), (bf16*)(ws + WS_WR)); }
    SEAM(0);
    if (IN(1)) { ph_ada_final_lnmod(lds, x, part, (const float*)args.in[I_BADA], ada, U); }
    SEAM(1);
    if (IN(2)) { pg8::Gemm g{U, (const bf16*)(ws + WS_WIN), T, INC, D, D, D}; pg8::StaticOrder S; S.init(T, INC, (int)gridDim.x, (int)blockIdx.x);
        pg8::EpiBf16<0> E{PROJ, INC, nullptr, 0, 0, 1.f};
        pg8::gemm_phase<pg8::EpiBf16<0>, pg8::StaticOrder, true, true>((PG8_LAS unsigned char*)lds_raw, g, S, E); }
    SEAM(2);
    if (IN(3)) { ph_ret_naive(lds, PROJ, rot, (const float*)args.in[I_GNW], MIX); }
    SEAM(3);
    if (IN(4)) { ph_pool_naive(lds, PROJ, (const float*)args.in[I_WPOOL], (const float*)args.in[I_PSCALE], MIX); }
    SEAM(4);
    if (IN(5)) { pg8::Gemm g{MIX, (const bf16*)(ws + WS_WOUT), T, D, D, D, D}; pg8::StaticOrder S; S.init(T, D, (int)gridDim.x, (int)blockIdx.x);
        pg8::EpiV1f E{x, ada, V1};
        pg8::gemm_phase<pg8::EpiV1f, pg8::StaticOrder, true, true>((PG8_LAS unsigned char*)lds_raw, g, S, E); }
    SEAM(5);
    if (IN(6)) { ph_ln1_ln2mod(V1, (const float*)args.in[I_LN1W], (const float*)args.in[I_LN1B], ada, U); }
    SEAM(6);
    if (IN(7)) { ph_router_naive(lds, U, (const float*)args.in[I_WGRP], (const float*)args.in[I_WRT], LOG); }
    SEAM(7);
    if (IN(8)) { ph_route(LOG, 1, (const float*)args.in[I_BGRP], (const float*)args.in[I_BRT], tok_e, tok_w); }
    SEAM(8);
    if (IN(9)) { ph_moe_naive(lds, U, tok_e, tok_w, (const float*)args.in[I_W1], (const float*)args.in[I_W3], (const float*)args.in[I_W2], Y2); }
    SEAM(9);
    if (IN(10)) { ph_final(V1, Y2, ada, (const float*)args.in[I_LN2W], (const float*)args.in[I_LN2B], args.out); }
#undef IN
#undef SEAM
}

extern "C" void kernel_launch(void* const* d_in, const int* in_sizes, int n_in, void* d_out, int out_size, void* d_ws, size_t ws_size, hipStream_t stream) {
    static int grid = 0;
    if (grid == 0) {
        if (n_in != 21 || in_sizes[0] != T * D || out_size != T * D || ws_size < WS_END) { fprintf(stderr, "kernel_launch: unexpected shapes (n_in %d, in0 %d, out %d, ws %zu)\n", n_in, n_in > 0 ? in_sizes[0] : -1, out_size, ws_size); grid = -1; return; }
        if (hipFuncSetAttribute((const void*)mk_fwd, hipFuncAttributeMaxDynamicSharedMemorySize, LDS_BYTES) != hipSuccess) { fprintf(stderr, "kernel_launch: hipFuncSetAttribute failed\n"); grid = -1; return; }
        int dev = 0, cus = 0, per_cu = 0;
        if (hipGetDevice(&dev) != hipSuccess || hipDeviceGetAttribute(&cus, hipDeviceAttributeMultiprocessorCount, dev) != hipSuccess) { grid = -1; return; }
        if (hipOccupancyMaxActiveBlocksPerMultiprocessor(&per_cu, (const void*)mk_fwd, NTHR, LDS_BYTES) != hipSuccess || per_cu < 1) { fprintf(stderr, "kernel_launch: occupancy query says %d blocks per CU\n", per_cu); (void)hipGetLastError(); per_cu = 1; }
        grid = cus;
        if (grid > NWG) grid = NWG;
    }
    if (grid < 0) return;
    Args a{};
    for (int i = 0; i < 21; ++i) a.in[i] = d_in[i];
    a.out = (float*)d_out; a.ws = (unsigned char*)d_ws;
    if (hipMemsetAsync((char*)d_ws + WS_CTL, 0, CTL_ZERO_BYTES, stream) != hipSuccess) { fprintf(stderr, "kernel_launch: hipMemsetAsync failed\n"); return; }
    a.ph_lo = 0; a.ph_hi = N_PHASES; a.li = 0;
    hipLaunchKernelGGL(mk_fwd, dim3(grid), dim3(NTHR), LDS_BYTES, stream, a);
}
```

```cpp
#include <hip/hip_runtime.h>
#include <cstdio>
#include <cstdint>

constexpr int NB = 8, SEQ = 2048, D = 1024, T = NB * SEQ;
constexpr int RW = 512, PW = 512, RH = 4, RD = 128;
constexpr int INC = 2560;
constexpr int NGRP = 4, EPG = 8, NE = 32, DE = 256;
constexpr int ADA = 6 * D;
constexpr float ALPHA = 1.189207115002721f;
constexpr float LN_EPS = 1e-5f;
constexpr int NWG = 256, NTHR = 512;

constexpr size_t MiB = 1u << 20;
constexpr size_t WS_CTL = 0, CTL_ZERO_BYTES = 64 * 1024;
constexpr size_t WS_ADAP = 1 * MiB;
constexpr size_t WS_ADA = 2 * MiB + 512 * 1024;
constexpr size_t WS_TOKE = 3 * MiB;
constexpr size_t WS_TOKW = WS_TOKE + 128 * 1024;
constexpr size_t WS_TOKS = WS_TOKE + 256 * 1024;
constexpr size_t WS_HIST = WS_TOKE + 384 * 1024;
constexpr size_t WS_SLOTW = WS_TOKE + 512 * 1024;
constexpr size_t WS_TILEE = WS_TOKE + 768 * 1024;
constexpr size_t WS_ROT = 4 * MiB;
constexpr size_t WS_WR = 12 * MiB;
constexpr size_t WS_WPOOL = 12 * MiB + 512 * 1024;
constexpr size_t WS_WIN = 13 * MiB;
constexpr size_t WS_WOUT = 18 * MiB;
constexpr size_t WS_W13 = 20 * MiB;
constexpr size_t WS_W2 = 52 * MiB;
constexpr size_t WS_U = 68 * MiB;
constexpr size_t WS_PROJ = 100 * MiB;
constexpr size_t WS_V1 = 100 * MiB;
constexpr size_t WS_LOG = 180 * MiB;
constexpr size_t WS_MIX = 212 * MiB;
constexpr size_t WS_Y2 = 164 * MiB;
constexpr size_t WS_U2S = 164 * MiB;
constexpr size_t WS_HS = 68 * MiB;
constexpr size_t WS_YS = 164 * MiB;
constexpr int MAXTILES = 160, MAXSLOT = MAXTILES * 256;
constexpr size_t WS_END = 256 * MiB;

typedef unsigned short bf16;
__device__ __forceinline__ unsigned f2bf(float f) { unsigned u = __builtin_bit_cast(unsigned, f); return (u + 0x7fffu + ((u >> 16) & 1u)) >> 16; }
__device__ __forceinline__ unsigned pk2(float lo, float hi) { return f2bf(lo) | (f2bf(hi) << 16); }
__device__ __forceinline__ float bflo(unsigned u) { return __builtin_bit_cast(float, u << 16); }
__device__ __forceinline__ float bfhi(unsigned u) { return __builtin_bit_cast(float, u & 0xffff0000u); }
__device__ __forceinline__ float bf2f(bf16 h) { return __builtin_bit_cast(float, (unsigned)h << 16); }
__device__ __forceinline__ float silu_f(float x) { return x / (1.0f + expf(-x)); }
__device__ __forceinline__ float wave_sum(float v) {
#pragma unroll
    for (int o = 1; o < 64; o <<= 1) v += __shfl_xor(v, o);
    return v;
}

struct Args { const void* in[21]; float* out; unsigned char* ws; int ph_lo, ph_hi, li, pad; };
enum { I_X = 0, I_C, I_POS, I_WADA, I_BADA, I_WIN, I_GNW, I_WPOOL, I_PSCALE, I_WOUT, I_LN1W, I_LN1B, I_WGRP, I_BGRP, I_WRT, I_BRT, I_W1, I_W3, I_W2, I_LN2W, I_LN2B };

template <class Epi>
__device__ __forceinline__ void naive_gemm(float* lds, const bf16* A, int lda, const float* W, int ldw, int M, int N, int K, const Epi& epi) {
    float* As = lds;
    float* Ws = lds + 16 * 132;
    const int tid = threadIdx.x, tx = tid & 31, ty = tid >> 5;
    const int ntn = N / 128, ntiles = (M / 128) * ntn;
    for (int tile = blockIdx.x; tile < ntiles; tile += gridDim.x) {
        const int tm = tile / ntn, tn = tile % ntn, row0 = tm * 128, col0 = tn * 128;
        float acc[8][4];
#pragma unroll
        for (int i = 0; i < 8; ++i)
#pragma unroll
            for (int j = 0; j < 4; ++j) acc[i][j] = 0.f;
        for (int k0 = 0; k0 < K; k0 += 16) {
            { const int r = tid >> 2, kq = (tid & 3) * 4; const uint2 raw = *(const uint2*)(A + (size_t)(row0 + r) * lda + k0 + kq);
              As[(kq + 0) * 132 + r] = bflo(raw.x); As[(kq + 1) * 132 + r] = bfhi(raw.x); As[(kq + 2) * 132 + r] = bflo(raw.y); As[(kq + 3) * 132 + r] = bfhi(raw.y); }
            { const int k = tid >> 5, n4 = (tid & 31) * 4; *(float4*)(Ws + k * 132 + n4) = *(const float4*)(W + (size_t)(k0 + k) * ldw + col0 + n4); }
            __syncthreads();
#pragma unroll
            for (int k = 0; k < 16; ++k) {
                const float4 a0 = *(const float4*)(As + k * 132 + ty * 8), a1 = *(const float4*)(As + k * 132 + ty * 8 + 4);
                const float4 w = *(const float4*)(Ws + k * 132 + tx * 4);
                const float av[8] = {a0.x, a0.y, a0.z, a0.w, a1.x, a1.y, a1.z, a1.w};
#pragma unroll
                for (int i = 0; i < 8; ++i) { acc[i][0] += av[i] * w.x; acc[i][1] += av[i] * w.y; acc[i][2] += av[i] * w.z; acc[i][3] += av[i] * w.w; }
            }
            __syncthreads();
        }
#pragma unroll
        for (int i = 0; i < 8; ++i) epi(row0 + ty * 8 + i, col0 + tx * 4, make_float4(acc[i][0], acc[i][1], acc[i][2], acc[i][3]));
    }
}

__device__ __forceinline__ void ph_ada_partial(float* lds, const float* c, const float* w_ada, float* part) {
    const int w = blockIdx.x, tid = threadIdx.x;
    if (w >= 96) return;
    const int cb = w % 12, kr = w / 12, c4 = tid & 127, ks = tid >> 7;
    float* cact = lds;
    float4* red = (float4*)(lds + 1024);
    for (int i = tid; i < 1024; i += NTHR) { const int b = i >> 7, kk = i & 127; cact[i] = silu_f(c[b * D + kr * 128 + kk]); }
    __syncthreads();
    float4 acc[8];
#pragma unroll
    for (int b = 0; b < 8; ++b) acc[b] = make_float4(0.f, 0.f, 0.f, 0.f);
    const int col = (cb * 128 + c4) * 4;
    for (int kk = 0; kk < 32; ++kk) {
        const int kl = ks * 32 + kk;
        const float4 wv = *(const float4*)(w_ada + (size_t)(kr * 128 + kl) * ADA + col);
#pragma unroll
        for (int b = 0; b < 8; ++b) { const float a = cact[b * 128 + kl]; acc[b].x += a * wv.x; acc[b].y += a * wv.y; acc[b].z += a * wv.z; acc[b].w += a * wv.w; }
    }
#pragma unroll
    for (int b = 0; b < 8; ++b) red[(ks * 8 + b) * 128 + c4] = acc[b];
    __syncthreads();
    for (int i = tid; i < 1024; i += NTHR) {
        const int b = i >> 7, cc = i & 127;
        float4 s = red[(0 * 8 + b) * 128 + cc];
#pragma unroll
        for (int q = 1; q < 4; ++q) { const float4 v = red[(q * 8 + b) * 128 + cc]; s.x += v.x; s.y += v.y; s.z += v.z; s.w += v.w; }
        *(float4*)(part + ((size_t)kr * 8 + b) * ADA + (cb * 128 + cc) * 4) = s;
    }
}
__device__ __forceinline__ void ph_rot_table(const int* pos, float2* rot) {
    const int gt = blockIdx.x * NTHR + threadIdx.x, GT = gridDim.x * NTHR;
    for (int idx = gt; idx < T * 64; idx += GT) {
        const int t = idx >> 6, i = idx & 63;
        const double inv = exp2(-(double)i * (13.287712379549449 / 64.0));
        const double ang = (double)pos[t] * inv;
        const double k = rint(ang * 0.15915494309189535);
        double r = fma(-k, 6.283185307179586, ang); r = fma(-k, 2.4492935982947064e-16, r);
        const float rf = (float)r;
        rot[idx] = make_float2(cosf(rf), sinf(rf));
    }
}
__device__ __forceinline__ void ph_ada_final_lnmod(float* lds, const float* x, const float* part, const float* b_ada, float* ada, bf16* U) {
    const int w = blockIdx.x, tid = threadIdx.x, lane = tid & 63, wave = tid >> 6, b = w >> 5;
    float* sh1 = lds; float* sc1 = lds + 1024;
    for (int j = tid; j < 2048; j += NTHR) { float s = b_ada[j]; for (int kr = 0; kr < 8; ++kr) s += part[((size_t)kr * 8 + b) * ADA + j]; if (j < 1024) sh1[j] = s; else sc1[j - 1024] = 1.0f + s; }
    { const int j0 = (w & 31) * 192; for (int j = tid; j < 192; j += NTHR) { float s = b_ada[j0 + j]; for (int kr = 0; kr < 8; ++kr) s += part[((size_t)kr * 8 + b) * ADA + j0 + j]; ada[(size_t)b * ADA + j0 + j] = s; } }
    __syncthreads();
    for (int i = 0; i < 8; ++i) {
        const int row = w * 64 + wave * 8 + i;
        const float4* xr = (const float4*)(x + (size_t)row * D) + lane;
        float4 v[4]; float s = 0.f;
#pragma unroll
        for (int j = 0; j < 4; ++j) { v[j] = xr[64 * j]; s += (v[j].x + v[j].y) + (v[j].z + v[j].w); }
        const float mean = wave_sum(s) * (1.f / D); float s2 = 0.f;
#pragma unroll
        for (int j = 0; j < 4; ++j) { v[j].x -= mean; v[j].y -= mean; v[j].z -= mean; v[j].w -= mean; s2 += (v[j].x * v[j].x + v[j].y * v[j].y) + (v[j].z * v[j].z + v[j].w * v[j].w); }
        const float rstd = 1.f / sqrtf(wave_sum(s2) * (1.f / D) + LN_EPS);
        uint2* o = (uint2*)(U + (size_t)row * D) + lane;
#pragma unroll
        for (int j = 0; j < 4; ++j) { const float4 sc = *(const float4*)(sc1 + 4 * lane + 256 * j), sh = *(const float4*)(sh1 + 4 * lane + 256 * j);
            o[64 * j] = make_uint2(pk2(v[j].x * rstd * sc.x + sh.x, v[j].y * rstd * sc.y + sh.y), pk2(v[j].z * rstd * sc.z + sh.z, v[j].w * rstd * sc.w + sh.w)); }
    }
}
__device__ __forceinline__ void ph_ret_naive(float* lds, const bf16* proj, const float2* rot, const float* gnw, bf16* mix) {
    const int w = blockIdx.x, tid = threadIdx.x;
    if (w >= 32) return;
    const int b = w >> 2, h = w & 3, e = tid & 127, dg = tid >> 7;
    const float gamma = 1.0f - exp2f(-5.0f - (float)h);
    float* Q = lds;
    float* Kk = lds + 4096;
    float* V = lds + 8192;
    float* red = lds + 12288;
    float Sx[32];
#pragma unroll
    for (int i = 0; i < 32; ++i) Sx[i] = 0.f;
    for (int t0 = 0; t0 < SEQ; t0 += 32) {
        __syncthreads();
        for (int it = tid; it < 32 * 64; it += NTHR) {
            const int r = it >> 6, i = it & 63; const size_t row = (size_t)b * SEQ + t0 + r;
            const float2 cs = rot[row * 64 + i];
            const bf16* pr = proj + row * INC;
            const float q1 = bf2f(pr[h * 128 + i]), q2 = bf2f(pr[h * 128 + 64 + i]);
            const float k1 = bf2f(pr[512 + h * 128 + i]), k2 = bf2f(pr[512 + h * 128 + 64 + i]);
            Q[r * 128 + i] = q1 * cs.x - q2 * cs.y; Q[r * 128 + 64 + i] = q1 * cs.y + q2 * cs.x;
            Kk[r * 128 + i] = (k1 * cs.x - k2 * cs.y) * 0.08838834764831845f; Kk[r * 128 + 64 + i] = (k1 * cs.y + k2 * cs.x) * 0.08838834764831845f;
            V[r * 128 + i] = bf2f(pr[1024 + h * 128 + i]); V[r * 128 + 64 + i] = bf2f(pr[1024 + h * 128 + 64 + i]);
        }
        __syncthreads();
        for (int r = 0; r < 32; ++r) {
            const float ve = V[r * 128 + e]; float o = 0.f;
#pragma unroll
            for (int dd = 0; dd < 32; ++dd) { const int d = dg * 32 + dd; Sx[dd] = gamma * Sx[dd] + Kk[r * 128 + d] * ve; o += Q[r * 128 + d] * Sx[dd]; }
            red[(r * 4 + dg) * 128 + e] = o;
        }
        __syncthreads();
        { const int lane = tid & 63, wave = tid >> 6;
          for (int rr = 0; rr < 4; ++rr) { const int r = wave * 4 + rr; const size_t row = (size_t)b * SEQ + t0 + r;
              float v0 = 0.f, v1 = 0.f;
#pragma unroll
              for (int q = 0; q < 4; ++q) { v0 += red[(r * 4 + q) * 128 + lane]; v1 += red[(r * 4 + q) * 128 + 64 + lane]; }
              const float mean = wave_sum(v0 + v1) * (1.f / 128.f); v0 -= mean; v1 -= mean;
              const float rstd = 1.f / sqrtf(wave_sum(v0 * v0 + v1 * v1) * (1.f / 128.f) + LN_EPS);
              const bf16* pr = proj + row * INC + 1536 + h * 128;
              const float g0 = bf2f(pr[lane]), g1 = bf2f(pr[64 + lane]);
              bf16* mo = mix + row * D + h * 128;
              mo[lane] = (bf16)f2bf(silu_f(g0) * (v0 * rstd * gnw[h * 128 + lane])); mo[64 + lane] = (bf16)f2bf(silu_f(g1) * (v1 * rstd * gnw[h * 128 + 64 + lane])); } }
    }
}
__device__ __forceinline__ void ph_pool_naive(float* lds, const bf16* proj, const float* w_pool, const float* pscale, bf16* mix) {
    const int tid = threadIdx.x;
    float* P = lds;
    for (int unit = blockIdx.x; unit < 256 * 4; unit += gridDim.x) {
        const int rb = unit >> 2, g = unit & 3, win = 2 << g, row0 = rb * 64;
        __syncthreads();
        for (int it = tid; it < 64 * 128; it += NTHR) {
            const int r = it >> 7, cc = it & 127; const int row = row0 + r, s = row & (SEQ - 1);
            const int cnt = (s + 1 < win) ? (s + 1) : win;
            float sum = 0.f;
            for (int j = 0; j < cnt; ++j) sum += bf2f(proj[(size_t)(row - j) * INC + 2048 + g * 128 + cc]);
            P[it] = sum / (float)cnt - bf2f(proj[(size_t)row * INC + 2048 + g * 128 + cc]);
        }
        __syncthreads();
        const int d = tid & 127, rg = tid >> 7;
        float acc[16];
#pragma unroll
        for (int i = 0; i < 16; ++i) acc[i] = 0.f;
        for (int cc = 0; cc < 128; ++cc) { const float wv = w_pool[((size_t)g * 128 + cc) * 128 + d];
#pragma unroll
            for (int i = 0; i < 16; ++i) acc[i] += P[(rg * 16 + i) * 128 + cc] * wv; }
        const float ps = pscale[g * 128 + d];
#pragma unroll
        for (int i = 0; i < 16; ++i) mix[(size_t)(row0 + rg * 16 + i) * D + 512 + g * 128 + d] = (bf16)f2bf(acc[i] * ps);
    }
}
__device__ __forceinline__ void ph_ln1_ln2mod(float* V1, const float* ln1w, const float* ln1b, const float* ada, bf16* U2) {
    const int tid = threadIdx.x, lane = tid & 63, wave = tid >> 6;
    for (int row = blockIdx.x * 8 + wave; row < T; row += gridDim.x * 8) {
        const int b = row / SEQ;
        float4* xr = (float4*)(V1 + (size_t)row * D) + lane;
        float4 v[4]; float s = 0.f;
#pragma unroll
        for (int j = 0; j < 4; ++j) { v[j] = xr[64 * j]; s += (v[j].x + v[j].y) + (v[j].z + v[j].w); }
        float mean = wave_sum(s) * (1.f / D); float s2 = 0.f;
#pragma unroll
        for (int j = 0; j < 4; ++j) { v[j].x -= mean; v[j].y -= mean; v[j].z -= mean; v[j].w -= mean; s2 += (v[j].x * v[j].x + v[j].y * v[j].y) + (v[j].z * v[j].z + v[j].w * v[j].w); }
        float rstd = 1.f / sqrtf(wave_sum(s2) * (1.f / D) + LN_EPS);
        s = 0.f;
#pragma unroll
        for (int j = 0; j < 4; ++j) { const float4 lw = *((const float4*)ln1w + lane + 64 * j), lb = *((const float4*)ln1b + lane + 64 * j);
            v[j].x = v[j].x * rstd * lw.x + lb.x; v[j].y = v[j].y * rstd * lw.y + lb.y; v[j].z = v[j].z * rstd * lw.z + lb.z; v[j].w = v[j].w * rstd * lw.w + lb.w;
            xr[64 * j] = v[j]; s += (v[j].x + v[j].y) + (v[j].z + v[j].w); }
        mean = wave_sum(s) * (1.f / D); s2 = 0.f;
#pragma unroll
        for (int j = 0; j < 4; ++j) { v[j].x -= mean; v[j].y -= mean; v[j].z -= mean; v[j].w -= mean; s2 += (v[j].x * v[j].x + v[j].y * v[j].y) + (v[j].z * v[j].z + v[j].w * v[j].w); }
        rstd = 1.f / sqrtf(wave_sum(s2) * (1.f / D) + LN_EPS);
        const float* sh2 = ada + (size_t)b * ADA + 3 * D; const float* sc2 = ada + (size_t)b * ADA + 4 * D;
        uint2* o = (uint2*)(U2 + (size_t)row * D) + lane;
#pragma unroll
        for (int j = 0; j < 4; ++j) { const float4 sc = *((const float4*)sc2 + lane + 64 * j), sh = *((const float4*)sh2 + lane + 64 * j);
            o[64 * j] = make_uint2(pk2(v[j].x * rstd * (1.f + sc.x) + sh.x, v[j].y * rstd * (1.f + sc.y) + sh.y), pk2(v[j].z * rstd * (1.f + sc.z) + sh.z, v[j].w * rstd * (1.f + sc.w) + sh.w)); }
    }
}
__device__ __forceinline__ void ph_router_naive(float* lds, const bf16* U2, const float* wg, const float* wr, float* logits) {
    const int tid = threadIdx.x, tl = tid >> 3, jg = tid & 7;
    float* Wl = lds;
    for (int blk = blockIdx.x; blk < T / 64; blk += gridDim.x) {
        const int t = blk * 64 + tl;
        float acc[5] = {0.f, 0.f, 0.f, 0.f, 0.f};
        for (int kh = 0; kh < 2; ++kh) {
            __syncthreads();
            for (int it = tid; it < 512 * 36; it += NTHR) { const int k = it / 36, j = it % 36; Wl[it] = (j < 4) ? wg[(size_t)(kh * 512 + k) * 4 + j] : wr[(size_t)(kh * 512 + k) * 32 + (j - 4)]; }
            __syncthreads();
            for (int k = 0; k < 512; ++k) { const float u = bf2f(U2[(size_t)t * D + kh * 512 + k]);
#pragma unroll
                for (int i = 0; i < 5; ++i) { const int j = jg + 8 * i; if (j < 36) acc[i] += u * Wl[k * 36 + j]; } }
        }
#pragma unroll
        for (int i = 0; i < 5; ++i) { const int j = jg + 8 * i; if (j < 36) logits[(size_t)t * 64 + j] = acc[i]; }
    }
}
__device__ __forceinline__ void ph_route(const float* logits, int npart, const float* bg, const float* br, int* tok_e, float* tok_w) {
    const int gt = blockIdx.x * NTHR + threadIdx.x, GT = gridDim.x * NTHR;
    for (int t = gt; t < T; t += GT) {
        float gl[4];
#pragma unroll
        for (int j = 0; j < 4; ++j) { float s = bg[j]; for (int p = 0; p < npart; ++p) s += logits[((size_t)p * T + t) * 64 + j]; gl[j] = s; }
        int gi = 0; float gm = gl[0];
#pragma unroll
        for (int j = 1; j < 4; ++j) if (gl[j] > gm) { gm = gl[j]; gi = j; }
        float den = 0.f;
#pragma unroll
        for (int j = 0; j < 4; ++j) den += expf(gl[j] - gm);
        const float gprob = 1.0f / den;
        float el[8];
#pragma unroll
        for (int i = 0; i < 8; ++i) { float s = 0.f; for (int p = 0; p < npart; ++p) s += logits[((size_t)p * T + t) * 64 + 4 + gi * 8 + i]; el[i] = s + br[gi * 8 + i]; }
        int i0 = 0; float v0 = el[0];
#pragma unroll
        for (int i = 1; i < 8; ++i) if (el[i] > v0) { v0 = el[i]; i0 = i; }
        int i1 = -1; float v1 = 0.f;
#pragma unroll
        for (int i = 0; i < 8; ++i) if (i != i0 && (i1 < 0 || el[i] > v1)) { v1 = el[i]; i1 = i; }
        const float ex = expf(v1 - v0), inv = 1.0f / (1.0f + ex);
        tok_e[2 * t] = gi * 8 + i0; tok_e[2 * t + 1] = gi * 8 + i1;
        tok_w[2 * t] = gprob * inv; tok_w[2 * t + 1] = gprob * ex * inv;
    }
}
__device__ __forceinline__ void ph_moe_naive(float* lds, const bf16* U2, const int* tok_e, const float* tok_w, const float* w1, const float* w3, const float* w2, float* Y2) {
    const int tid = threadIdx.x;
    float* u = lds;
    float* pa = lds + 1024;
    float* pb = lds + 1536;
    float* hh = lds + 2048;
    for (int t = blockIdx.x; t < T; t += gridDim.x) {
        __syncthreads();
        for (int i = tid; i < D; i += NTHR) u[i] = bf2f(U2[(size_t)t * D + i]);
        float y0 = 0.f, y1 = 0.f;
        for (int k = 0; k < 2; ++k) {
            const int e = tok_e[2 * t + k]; const float wgt = tok_w[2 * t + k];
            __syncthreads();
            { const int f = tid & 255, hf = tid >> 8; const float* p1 = w1 + ((size_t)e * D + hf * 512) * DE + f; const float* p3 = w3 + ((size_t)e * D + hf * 512) * DE + f;
              float a = 0.f, bq = 0.f;
              for (int d = 0; d < 512; ++d) { const float uv = u[hf * 512 + d]; a += uv * p1[(size_t)d * DE]; bq += uv * p3[(size_t)d * DE]; }
              pa[hf * 256 + f] = a; pb[hf * 256 + f] = bq; }
            __syncthreads();
            if (tid < 256) { const float a = pa[tid] + pa[256 + tid], bq = pb[tid] + pb[256 + tid]; hh[tid] = silu_f(a) * bq * wgt; }
            __syncthreads();
            { const float* p2 = w2 + (size_t)e * DE * D + tid;
              for (int f = 0; f < 256; ++f) { const float hv = hh[f]; y0 += hv * p2[(size_t)f * D]; y1 += hv * p2[(size_t)f * D + 512]; } }
        }
        Y2[(size_t)t * D + tid] = y0; Y2[(size_t)t * D + 512 + tid] = y1;
    }
}
__device__ __forceinline__ void ph_final(const float* X1, const float* Y2, const float* ada, const float* ln2w, const float* ln2b, float* out) {
    const int tid = threadIdx.x, lane = tid & 63, wave = tid >> 6;
    for (int row = blockIdx.x * 8 + wave; row < T; row += gridDim.x * 8) {
        const int b = row / SEQ;
        const float4* xr = (const float4*)(X1 + (size_t)row * D) + lane; const float4* yr = (const float4*)(Y2 + (size_t)row * D) + lane;
        const float4* g2 = (const float4*)(ada + (size_t)b * ADA + 5 * D) + lane;
        float4 v[4]; float s = 0.f;
#pragma unroll
        for (int j = 0; j < 4; ++j) { const float4 xv = xr[64 * j], yv = yr[64 * j], gv = g2[64 * j];
            v[j].x = ALPHA * xv.x + gv.x * yv.x; v[j].y = ALPHA * xv.y + gv.y * yv.y; v[j].z = ALPHA * xv.z + gv.z * yv.z; v[j].w = ALPHA * xv.w + gv.w * yv.w; s += (v[j].x + v[j].y) + (v[j].z + v[j].w); }
        const float mean = wave_sum(s) * (1.f / D); float s2 = 0.f;
#pragma unroll
        for (int j = 0; j < 4; ++j) { v[j].x -= mean; v[j].y -= mean; v[j].z -= mean; v[j].w -= mean; s2 += (v[j].x * v[j].x + v[j].y * v[j].y) + (v[j].z * v[j].z + v[j].w * v[j].w); }
        const float rstd = 1.f / sqrtf(wave_sum(s2) * (1.f / D) + LN_EPS);
        float4* o = (float4*)(out + (size_t)row * D) + lane;
#pragma unroll
        for (int j = 0; j < 4; ++j) { const float4 lw = *((const float4*)ln2w + lane + 64 * j), lb = *((const float4*)ln2b + lane + 64 * j);
            o[64 * j] = make_float4(v[j].x * rstd * lw.x + lb.x, v[j].y * rstd * lw.y + lb.y, v[j].z * rstd * lw.z + lb.z, v[j].w * rstd * lw.w + lb.w); }
    }
}


__device__ __forceinline__ void ph_route_hist(float* lds, const float* logits, int npart, const float* bg, const float* br, int* tok_e, float* tok_w, int* hist) {
    const int tid = threadIdx.x; int* h = (int*)lds;
    for (int blk = blockIdx.x; blk < T / 64; blk += gridDim.x) {
        __syncthreads();
        if (tid < 32) h[tid] = 0;
        __syncthreads();
        if (tid < 64) {
            const int t = blk * 64 + tid;
            float gl[4];
#pragma unroll
            for (int j = 0; j < 4; ++j) { float s = bg[j]; for (int p = 0; p < npart; ++p) s += logits[((size_t)p * T + t) * 64 + j]; gl[j] = s; }
            int gi = 0; float gm = gl[0];
#pragma unroll
            for (int j = 1; j < 4; ++j) if (gl[j] > gm) { gm = gl[j]; gi = j; }
            float den = 0.f;
#pragma unroll
            for (int j = 0; j < 4; ++j) den += expf(gl[j] - gm);
            const float gprob = 1.0f / den;
            float el[8];
#pragma unroll
            for (int i = 0; i < 8; ++i) { float s = 0.f; for (int p = 0; p < npart; ++p) s += logits[((size_t)p * T + t) * 64 + 4 + gi * 8 + i]; el[i] = s + br[gi * 8 + i]; }
            int i0 = 0; float v0 = el[0];
#pragma unroll
            for (int i = 1; i < 8; ++i) if (el[i] > v0) { v0 = el[i]; i0 = i; }
            int i1 = -1; float v1 = 0.f;
#pragma unroll
            for (int i = 0; i < 8; ++i) if (i != i0 && (i1 < 0 || el[i] > v1)) { v1 = el[i]; i1 = i; }
            const float ex = expf(v1 - v0), inv = 1.0f / (1.0f + ex);
            tok_e[2 * t] = gi * 8 + i0; tok_e[2 * t + 1] = gi * 8 + i1;
            tok_w[2 * t] = gprob * inv; tok_w[2 * t + 1] = gprob * ex * inv;
            atomicAdd(&h[gi * 8 + i0], 1); atomicAdd(&h[gi * 8 + i1], 1);
        }
        __syncthreads();
        if (tid < 32) hist[blk * 32 + tid] = h[tid];
    }
}
__device__ __forceinline__ void ph_permute(float* lds, const int* hist, const int* tok_e, const float* tok_w, const bf16* U2, int* tok_slot, float* slot_w, int* tile_e, bf16* U2s) {
    const int tid = threadIdx.x, lane = tid & 63, wave = tid >> 6;
    int* cnt = (int*)lds; int* pre = cnt + 32; int* base = cnt + 64; int* ee = cnt + 128; int* ss = cnt + 256;
    for (int blk = blockIdx.x; blk < T / 64; blk += gridDim.x) {
        __syncthreads();
        if (tid < 32) { int c = 0, p = 0; for (int w = 0; w < T / 64; ++w) { const int v = hist[w * 32 + tid]; c += v; if (w < blk) p += v; } cnt[tid] = c; pre[tid] = p; }
        if (tid >= 64 && tid < 192) ee[tid - 64] = tok_e[blk * 128 + (tid - 64)];
        __syncthreads();
        if (tid == 0) { int b = 0; for (int e = 0; e < 32; ++e) { base[e] = b; b += (cnt[e] + 255) & ~255; } base[32] = b; }
        __syncthreads();
        if (tid < 128) { const int e = ee[tid]; int rank = 0; for (int j = 0; j < tid; ++j) rank += (ee[j] == e) ? 1 : 0;
            const int slot = base[e] + pre[e] + rank; ss[tid] = slot; tok_slot[blk * 128 + tid] = slot; slot_w[slot] = tok_w[blk * 128 + tid]; }
        if (blk == 0 && tid >= 256 && tid < 256 + 32) { const int e = tid - 256; const int t0 = base[e] >> 8, t1 = base[e + 1] >> 8; for (int q = t0; q < t1; ++q) tile_e[q] = e; if (e == 0) tile_e[MAXTILES] = base[32] >> 8; }
        __syncthreads();
        for (int i = wave; i < 128; i += 8) { const int t = blk * 64 + (i >> 1); const uint4* s = (const uint4*)(U2 + (size_t)t * D); uint4* d = (uint4*)(U2s + (size_t)ss[i] * D);
            d[lane] = s[lane]; d[lane + 64] = s[lane + 64]; }
    }
}
__device__ __forceinline__ void ph_final_slots(const float* X1, const bf16* Ys, const int* tok_slot, const float* ada, const float* ln2w, const float* ln2b, float* out) {
    const int tid = threadIdx.x, lane = tid & 63, wave = tid >> 6;
    for (int row = blockIdx.x * 8 + wave; row < T; row += gridDim.x * 8) {
        const int b = row / SEQ; const int s0 = tok_slot[2 * row], s1 = tok_slot[2 * row + 1];
        const float4* xr = (const float4*)(X1 + (size_t)row * D) + lane;
        const uint2* y0 = (const uint2*)(Ys + (size_t)s0 * D) + lane; const uint2* y1 = (const uint2*)(Ys + (size_t)s1 * D) + lane;
        const float4* g2 = (const float4*)(ada + (size_t)b * ADA + 5 * D) + lane;
        float4 v[4]; float s = 0.f;
#pragma unroll
        for (int j = 0; j < 4; ++j) { const float4 xv = xr[64 * j], gv = g2[64 * j]; const uint2 a = y0[64 * j], c = y1[64 * j];
            v[j].x = ALPHA * xv.x + gv.x * (bflo(a.x) + bflo(c.x)); v[j].y = ALPHA * xv.y + gv.y * (bfhi(a.x) + bfhi(c.x));
            v[j].z = ALPHA * xv.z + gv.z * (bflo(a.y) + bflo(c.y)); v[j].w = ALPHA * xv.w + gv.w * (bfhi(a.y) + bfhi(c.y)); s += (v[j].x + v[j].y) + (v[j].z + v[j].w); }
        const float mean = wave_sum(s) * (1.f / D); float s2 = 0.f;
#pragma unroll
        for (int j = 0; j < 4; ++j) { v[j].x -= mean; v[j].y -= mean; v[j].z -= mean; v[j].w -= mean; s2 += (v[j].x * v[j].x + v[j].y * v[j].y) + (v[j].z * v[j].z + v[j].w * v[j].w); }
        const float rstd = 1.f / sqrtf(wave_sum(s2) * (1.f / D) + LN_EPS);
        float4* o = (float4*)(out + (size_t)row * D) + lane;
#pragma unroll
        for (int j = 0; j < 4; ++j) { const float4 lw = *((const float4*)ln2w + lane + 64 * j), lb = *((const float4*)ln2b + lane + 64 * j);
            o[64 * j] = make_float4(v[j].x * rstd * lw.x + lb.x, v[j].y * rstd * lw.y + lb.y, v[j].z * rstd * lw.z + lb.z, v[j].w * rstd * lw.w + lb.w); }
    }
}

struct EpiStoreBf16 { bf16* O; int ldc; __device__ __forceinline__ void operator()(int row, int col, float4 a) const { *(uint2*)(O + (size_t)row * ldc + col) = make_uint2(pk2(a.x, a.y), pk2(a.z, a.w)); } };
struct EpiV1 { const float* x; const float* ada; float* V1;
    __device__ __forceinline__ void operator()(int row, int col, float4 a) const { const int b = row / SEQ; const float4 xv = *(const float4*)(x + (size_t)row * D + col), g = *(const float4*)(ada + (size_t)b * ADA + 2 * D + col);
        *(float4*)(V1 + (size_t)row * D + col) = make_float4(ALPHA * xv.x + g.x * a.x, ALPHA * xv.y + g.y * a.y, ALPHA * xv.z + g.z * a.z, ALPHA * xv.w + g.w * a.w); } };


namespace pg8 {
#define PG8_LAS __attribute__((address_space(3)))
typedef unsigned short bf16_t;
typedef short bf16x8 __attribute__((ext_vector_type(8)));
typedef float f32x4 __attribute__((ext_vector_type(4)));
typedef unsigned u32x4 __attribute__((ext_vector_type(4)));
constexpr int BM = 256, BK = 64, HALF = 128, HTB = HALF * BK * 2  , STAGE_BYTES = 8 * HTB, NXCD = 8, WGM = 8;

__host__ __device__ __forceinline__ int lds_byte(int r, int c) { const int st = (r >> 4) * 2 + (c >> 5), rr = r & 15, cc = c & 31, ob = rr * 64 + cc * 2; return st * 1024 + (ob ^ (((ob >> 9) & 1) << 5)); }
__host__ __device__ __forceinline__ void stage_rc(int b, int& R, int& C) { const int st = b / 1024, sb = b % 1024, swz = sb ^ (((sb >> 9) & 1) << 5); R = (st >> 1) * 16 + swz / 64; C = (st & 1) * 32 + (swz % 64) / 2; }
__host__ __device__ __forceinline__ int perm32(int rho) { const int n = rho >> 4, i = rho & 15; return 8 * (i >> 2) + 4 * n + (i & 3); }

struct Unit { int pm, pn, ka; };
struct Gemm { const bf16_t* A; const bf16_t* Bt; int M, N, K, lda, ldb; };

struct StaticOrder {
    int nM, nN, nwg, G, c;
    __host__ __device__ void init(int M, int N, int G_, int c_) { nM = M / BM; nN = N / BM; nwg = nM * nN; G = G_; c = c_; }
    __host__ __device__ bool next(int i, Unit& u) const {
        const long L = (long)i * G + c; if (L >= nwg) return false;
        int wgid = (int)L; { const int q = nwg / NXCD, r = nwg % NXCD, xcd = wgid % NXCD, off = wgid / NXCD; wgid = (xcd < r ? xcd * (q + 1) : r * (q + 1) + (xcd - r) * q) + off; }
        const int nig = WGM * nN, gid = wgid / nig, fm = gid * WGM, gsz = (nM - fm) < WGM ? (nM - fm) : WGM;
        u.pm = fm + ((wgid % nig) % gsz); u.pn = (wgid % nig) / gsz; u.ka = 0; return true;
    }
    __device__ __forceinline__ void a_ready(const Unit&) const {}
    __device__ __forceinline__ void done(const Unit&) const {}
};

__device__ __forceinline__ unsigned cvt_pk_bf16(float lo, float hi) { unsigned r; asm volatile("v_cvt_pk_bf16_f32 %0, %1, %2" : "=v"(r) : "v"(lo), "v"(hi)); return r; }
typedef float f32x2 __attribute__((ext_vector_type(2)));
__device__ __forceinline__ f32x2 gelu_pk(f32x2 v) { return v; }
template <int ACT  > struct EpiBf16 {
    static constexpr bool PERM = true, AFTER_DRAIN = false; static_assert(ACT == 0 || ACT == 1, "EpiBf16: ACT is 0 (none) or 1 (gelu_pk)");
    bf16_t* O; int ldc; const float* bias; int split_cols; size_t split_stride; float scale0;
    __device__ __forceinline__ void operator()(const f32x4 (&acc)[2][2][4][2], const Unit& u, int wr, int wc, int fr, int fq) const {
        const int row0 = u.pm * BM + wr * 64 + fr; int colt = u.pn * BM; bf16_t* base = O;
        float sc = 1.f; if (split_cols) { const int t = colt / split_cols; base += (size_t)t * split_stride; colt -= t * split_cols; if (t == 0) sc = scale0; }
        const int col0 = colt + wc * 32 + 8 * fq, bcol0 = u.pn * BM + wc * 32 + 8 * fq;
        f32x4 bv[2][2];
#pragma unroll
        for (int bj = 0; bj < 2; ++bj)
#pragma unroll
            for (int n = 0; n < 2; ++n) bv[bj][n] = bias ? *(const f32x4*)(bias + bcol0 + bj * HALF + 4 * n) : (f32x4){0.f, 0.f, 0.f, 0.f};
#pragma unroll
        for (int ai = 0; ai < 2; ++ai)
#pragma unroll
            for (int m = 0; m < 4; ++m) { bf16_t* rowp = base + (size_t)(row0 + ai * HALF + m * 16) * ldc + col0;
#pragma unroll
                for (int bj = 0; bj < 2; ++bj) { f32x4 v0 = acc[ai][bj][m][0] + bv[bj][0], v1 = acc[ai][bj][m][1] + bv[bj][1];
                    if (ACT == 1) { f32x2 a = gelu_pk((f32x2){v0[0], v0[1]}), b = gelu_pk((f32x2){v0[2], v0[3]}), c = gelu_pk((f32x2){v1[0], v1[1]}), d = gelu_pk((f32x2){v1[2], v1[3]});
                        v0 = (f32x4){a.x, a.y, b.x, b.y}; v1 = (f32x4){c.x, c.y, d.x, d.y}; }
                    v0 = v0 * sc; v1 = v1 * sc; u32x4 w; w.x = cvt_pk_bf16(v0[0], v0[1]); w.y = cvt_pk_bf16(v0[2], v0[3]); w.z = cvt_pk_bf16(v1[0], v1[1]); w.w = cvt_pk_bf16(v1[2], v1[3]);
                    *(u32x4*)(rowp + bj * HALF) = w; } }
    }
};

struct EpiV1f {
    static constexpr bool PERM = false, AFTER_DRAIN = false;
    const float* x; const float* ada; float* V1;
    __device__ __forceinline__ void operator()(const f32x4 (&acc)[2][2][4][2], const Unit& u, int wr, int wc, int fr, int fq) const {
        const int row0 = u.pm * BM + wr * 64 + fr, col0 = u.pn * BM + wc * 32 + 4 * fq; const int b = (u.pm * BM) / 2048;
        f32x4 gv[2][2];
#pragma unroll
        for (int bj = 0; bj < 2; ++bj)
#pragma unroll
            for (int n = 0; n < 2; ++n) gv[bj][n] = *(const f32x4*)(ada + (size_t)b * 6144 + 2048 + col0 + bj * HALF + n * 16);
#pragma unroll
        for (int ai = 0; ai < 2; ++ai)
#pragma unroll
            for (int m = 0; m < 4; ++m) { const size_t off = (size_t)(row0 + ai * HALF + m * 16) * 1024 + col0;
#pragma unroll
                for (int bj = 0; bj < 2; ++bj)
#pragma unroll
                    for (int n = 0; n < 2; ++n) { const f32x4 xv = *(const f32x4*)(x + off + bj * HALF + n * 16);
                        *(f32x4*)(V1 + off + bj * HALF + n * 16) = xv * 1.189207115002721f + gv[bj][n] * acc[ai][bj][m][n]; } }
    }
};


template <int NSUB> struct MoeOrder {
    const int* tile_e; int nunits, G, c;
    __device__ void init(const int* te, int G_, int c_) { tile_e = te; nunits = te[160] * NSUB; G = G_; c = c_; }
    __device__ bool next(int i, Unit& u) const { const int L = i * G + c; if (L >= nunits) return false; u.pm = L / NSUB; u.pn = tile_e[u.pm] * NSUB + (L % NSUB); u.ka = 0; return true; }
    __device__ __forceinline__ void a_ready(const Unit&) const {}
    __device__ __forceinline__ void done(const Unit&) const {}
};
struct EpiMoeUp {
    static constexpr bool PERM = true, AFTER_DRAIN = false;
    bf16_t* Hs; const float* slot_w;
    __device__ __forceinline__ void operator()(const f32x4 (&acc)[2][2][4][2], const Unit& u, int wr, int wc, int fr, int fq) const {
        const int row0 = u.pm * BM + wr * 64 + fr, col0 = (u.pn & 1) * HALF + wc * 32 + 8 * fq;
#pragma unroll
        for (int ai = 0; ai < 2; ++ai)
#pragma unroll
            for (int m = 0; m < 4; ++m) { const int slot = row0 + ai * HALF + m * 16; const float w = slot_w[slot];
                float hv[8];
#pragma unroll
                for (int n = 0; n < 2; ++n)
#pragma unroll
                    for (int j = 0; j < 4; ++j) { const float a = acc[ai][0][m][n][j], b = acc[ai][1][m][n][j]; hv[4 * n + j] = a * __builtin_amdgcn_rcpf(1.0f + __builtin_amdgcn_exp2f(-1.4426950408889634f * a)) * b * w; }
                u32x4 o; o.x = cvt_pk_bf16(hv[0], hv[1]); o.y = cvt_pk_bf16(hv[2], hv[3]); o.z = cvt_pk_bf16(hv[4], hv[5]); o.w = cvt_pk_bf16(hv[6], hv[7]);
                *(u32x4*)(Hs + (size_t)slot * 256 + col0) = o; }
    }
};

template <class Epi, class Sched, bool ALIGN_EPI = false, bool SP2 = false>
__device__ __forceinline__ void gemm_phase(PG8_LAS unsigned char* lds, const Gemm g, const Sched& S, const Epi& E) {
    const int tid = threadIdx.x, wid = __builtin_amdgcn_readfirstlane(tid >> 6), lane = tid & 63, wr = wid >> 2, wc = wid & 3, fr = lane & 15, fq = lane >> 4;
    const int K = g.K, nt = K / BK;
    unsigned voffA[2], voffB[2];
#pragma unroll
    for (int i = 0; i < 2; ++i) { int R, C; stage_rc(tid * 16 + i * 8192, R, C); const int Rb = Epi::PERM ? ((R & ~31) + perm32(R & 31)) : R;
        voffA[i] = (unsigned)(R * g.lda + C) * 2u; voffB[i] = (unsigned)(Rb * g.ldb + C) * 2u; }
    const size_t kstep = (size_t)(BK * 2);
    const size_t hstepA = (size_t)HALF * g.lda * 2, hstepB = (size_t)HALF * g.ldb * 2;
    const size_t tstepA = 2 * hstepA, tstepB = 2 * hstepB;
    const unsigned ldsw = (unsigned)wid * 1024u;
    const int aoff = lds_byte(wr * 64 + fr, fq * 8), boff = lds_byte(wc * 32 + fr, fq * 8);
#define PG8_SA(b, h) (((b) * 2 + (h)) * HTB)
#define PG8_SB(b, h) ((4 + (b) * 2 + (h)) * HTB)
#define PG8_STAGE(bufoff, gbase, voff) do { _Pragma("unroll") for (int _i = 0; _i < 2; ++_i) \
        __builtin_amdgcn_global_load_lds((const unsigned*)((const char*)(gbase) + (voff)[_i]), (PG8_LAS unsigned*)(lds + (bufoff) + ldsw + _i * 8192), 16, 0, 0); } while (0)
#define PG8_LDA(dst, b, h) do { _Pragma("unroll") for (int m = 0; m < 4; ++m) _Pragma("unroll") for (int k = 0; k < 2; ++k) dst[m][k] = *(const PG8_LAS bf16x8*)(lds + PG8_SA(b, h) + aoff + m * 2048 + k * 1024); } while (0)
#define PG8_LDB(dst, b, h) do { _Pragma("unroll") for (int n = 0; n < 2; ++n) _Pragma("unroll") for (int k = 0; k < 2; ++k) dst[n][k] = *(const PG8_LAS bf16x8*)(lds + PG8_SB(b, h) + boff + n * 2048 + k * 1024); } while (0)
#define PG8_MMA(ai, bj, At, Bt) do { __builtin_amdgcn_s_setprio(1); _Pragma("unroll") for (int m = 0; m < 4; ++m) _Pragma("unroll") for (int n = 0; n < 2; ++n) _Pragma("unroll") for (int k = 0; k < 2; ++k) \
        acc[ai][bj][m][n] = __builtin_amdgcn_mfma_f32_16x16x32_bf16(Bt[n][k], At[m][k], acc[ai][bj][m][n], 0, 0, 0); __builtin_amdgcn_s_setprio(0); } while (0)
#define PG8_WAIT_V(n) asm volatile("s_waitcnt vmcnt(" #n ")" ::: "memory")
#define PG8_WAIT_L(n) asm volatile("s_waitcnt lgkmcnt(" #n ")" ::: "memory")
#define PG8_BAR __builtin_amdgcn_s_barrier()
#define PG8_SCHED __builtin_amdgcn_sched_barrier(0)
    Unit cur, nxt; int ui = 0;
    if (!S.next(0, cur)) return;
    f32x4 acc[2][2][4][2];
#pragma unroll
    for (int a = 0; a < 2; ++a)
#pragma unroll
        for (int b = 0; b < 2; ++b)
#pragma unroll
            for (int m = 0; m < 4; ++m)
#pragma unroll
                for (int n = 0; n < 2; ++n) acc[a][b][m][n] = (f32x4){0.f, 0.f, 0.f, 0.f};
    bf16x8 At[4][2], B0[2][2], B1[2][2];
    const char* cA = (const char*)g.A + (size_t)cur.pm * tstepA + (size_t)cur.ka * 2; const char* cB = (const char*)g.Bt + (size_t)cur.pn * tstepB + (size_t)cur.ka * 2;
    S.a_ready(cur);
    if constexpr (SP2) {
        PG8_STAGE(PG8_SB(0, 0), cB, voffB); PG8_STAGE(PG8_SB(0, 1), cB + hstepB, voffB); PG8_STAGE(PG8_SA(0, 0), cA, voffA); PG8_STAGE(PG8_SA(0, 1), cA + hstepA, voffA);
        if (wr == 1) PG8_BAR;
        PG8_WAIT_V(2); PG8_BAR;
        PG8_STAGE(PG8_SB(1, 0), cB + kstep, voffB); PG8_STAGE(PG8_SA(1, 0), cA + kstep, voffA); PG8_STAGE(PG8_SB(1, 1), cB + hstepB + kstep, voffB);
        PG8_WAIT_V(6); PG8_BAR;
    } else {
        PG8_STAGE(PG8_SB(0, 0), cB, voffB); PG8_STAGE(PG8_SA(0, 0), cA, voffA); PG8_STAGE(PG8_SB(0, 1), cB + hstepB, voffB); PG8_STAGE(PG8_SA(0, 1), cA + hstepA, voffA);
        if (wr == 1) PG8_BAR;
        PG8_WAIT_V(4); PG8_BAR;
        PG8_STAGE(PG8_SB(1, 0), cB + kstep, voffB); PG8_STAGE(PG8_SA(1, 0), cA + kstep, voffA); PG8_STAGE(PG8_SB(1, 1), cB + hstepB + kstep, voffB);
        PG8_WAIT_V(6); PG8_BAR;
    }
    for (;;) {
        const bool has_next = S.next(ui + 1, nxt);
        const char* nA = has_next ? (const char*)g.A + (size_t)nxt.pm * tstepA + (size_t)nxt.ka * 2 : cA; const char* nB = has_next ? (const char*)g.Bt + (size_t)nxt.pn * tstepB + (size_t)nxt.ka * 2 : cB;
        for (int t = 0; t < nt; t += 2) {
            const bool last = (t == nt - 2);
            const char* a1 = cA + (size_t)(t + 1) * kstep;
            const char* a2 = last ? nA : cA + (size_t)(t + 2) * kstep; const char* b2 = last ? nB : cB + (size_t)(t + 2) * kstep;
            const char* a3 = a2 + kstep; const char* b3 = b2 + kstep;
            if (last && has_next) S.a_ready(nxt);
            if constexpr (SP2) {
            PG8_LDB(B0, 0, 0); PG8_LDB(B1, 0, 1); PG8_SCHED; PG8_LDA(At, 0, 0); PG8_STAGE(PG8_SA(1, 1), a1 + hstepA, voffA);
            PG8_WAIT_V(8); PG8_WAIT_L(0); PG8_BAR; PG8_MMA(0, 0, At, B0); PG8_MMA(0, 1, At, B1); PG8_BAR; PG8_SCHED;
            PG8_LDA(At, 0, 1); PG8_STAGE(PG8_SB(0, 0), b2, voffB); PG8_STAGE(PG8_SB(0, 1), b2 + hstepB, voffB); PG8_STAGE(PG8_SA(0, 0), a2, voffA);
            PG8_WAIT_V(8); PG8_WAIT_L(0); PG8_BAR; PG8_MMA(1, 0, At, B0); PG8_MMA(1, 1, At, B1); PG8_BAR; PG8_SCHED;
            PG8_LDB(B0, 1, 0); PG8_LDB(B1, 1, 1); PG8_SCHED; PG8_LDA(At, 1, 0); PG8_STAGE(PG8_SA(0, 1), a2 + hstepA, voffA);
            PG8_WAIT_V(8); PG8_WAIT_L(0); PG8_BAR; PG8_MMA(0, 0, At, B0); PG8_MMA(0, 1, At, B1); PG8_BAR; PG8_SCHED;
            PG8_LDA(At, 1, 1); PG8_STAGE(PG8_SB(1, 0), b3, voffB); PG8_STAGE(PG8_SB(1, 1), b3 + hstepB, voffB); PG8_STAGE(PG8_SA(1, 0), a3, voffA);
            PG8_WAIT_V(8); PG8_WAIT_L(0); PG8_BAR; PG8_MMA(1, 0, At, B0); PG8_MMA(1, 1, At, B1); PG8_BAR; PG8_SCHED;
            } else {
            PG8_LDB(B0, 0, 0); PG8_SCHED; PG8_LDA(At, 0, 0); PG8_STAGE(PG8_SA(1, 1), a1 + hstepA, voffA);
            PG8_WAIT_L(8); PG8_BAR; PG8_WAIT_L(0); PG8_MMA(0, 0, At, B0); PG8_BAR; PG8_SCHED;
            PG8_LDB(B1, 0, 1); PG8_STAGE(PG8_SB(0, 0), b2, voffB);
            PG8_BAR; PG8_WAIT_L(0); PG8_MMA(0, 1, At, B1); PG8_BAR;
            PG8_LDA(At, 0, 1); PG8_STAGE(PG8_SA(0, 0), a2, voffA);
            PG8_BAR; PG8_WAIT_L(0); PG8_MMA(1, 0, At, B0); PG8_BAR; PG8_SCHED;
            PG8_STAGE(PG8_SB(0, 1), b2 + hstepB, voffB);
            PG8_WAIT_V(6); PG8_BAR; PG8_MMA(1, 1, At, B1); PG8_BAR;
            PG8_LDB(B0, 1, 0); PG8_SCHED; PG8_LDA(At, 1, 0); PG8_STAGE(PG8_SA(0, 1), a2 + hstepA, voffA);
            PG8_WAIT_L(8); PG8_BAR; PG8_WAIT_L(0); PG8_MMA(0, 0, At, B0); PG8_BAR; PG8_SCHED;
            PG8_LDB(B1, 1, 1); PG8_STAGE(PG8_SB(1, 0), b3, voffB);
            PG8_BAR; PG8_WAIT_L(0); PG8_MMA(0, 1, At, B1); PG8_BAR;
            PG8_LDA(At, 1, 1); PG8_STAGE(PG8_SA(1, 0), a3, voffA);
            PG8_BAR; PG8_WAIT_L(0); PG8_MMA(1, 0, At, B0); PG8_BAR; PG8_SCHED;
            PG8_STAGE(PG8_SB(1, 1), b3 + hstepB, voffB);
            PG8_WAIT_V(6); PG8_BAR; PG8_MMA(1, 1, At, B1); PG8_BAR;
            }
        }
        if constexpr (ALIGN_EPI) { if (wr == 0) PG8_BAR; }
        if constexpr (!Epi::AFTER_DRAIN) { E(acc, cur, wr, wc, fr, fq); S.done(cur); }
        if (!has_next) break;
#pragma unroll
        for (int a = 0; a < 2; ++a)
#pragma unroll
            for (int b = 0; b < 2; ++b)
#pragma unroll
                for (int m = 0; m < 4; ++m)
#pragma unroll
                    for (int n = 0; n < 2; ++n) acc[a][b][m][n] = (f32x4){0.f, 0.f, 0.f, 0.f};
        cur = nxt; cA = nA; cB = nB; ++ui;
        if constexpr (ALIGN_EPI) { if (wr == 1) PG8_BAR; }
    }
    PG8_WAIT_V(0);
    if constexpr (!ALIGN_EPI) { if (wr == 0) PG8_BAR; }
    PG8_BAR;
    if constexpr (Epi::AFTER_DRAIN) { E.fused(acc, cur, wr, wc, fr, fq, lds, wid, lane); S.done(cur); }
#undef PG8_SA
#undef PG8_SB
#undef PG8_STAGE
#undef PG8_LDA
#undef PG8_LDB
#undef PG8_MMA
#undef PG8_WAIT_V
#undef PG8_WAIT_L
#undef PG8_BAR
#undef PG8_SCHED
}
}

__device__ __forceinline__ void p0_transpose_item(const float* W, int K, int N, bf16* WT, int row_off, float* scr, int item, int lane) {
    const int nblk = N / 32, kb = item / nblk, nb = item % nblk, k0 = 64 * kb, n0 = 32 * nb;
#pragma unroll 8
    for (int i = 0; i < 32; ++i) { const int kk = 2 * i + (lane >> 5); scr[kk * 33 + (lane & 31)] = W[(size_t)(k0 + kk) * N + n0 + (lane & 31)]; }
    asm volatile("s_waitcnt lgkmcnt(0)" ::: "memory");
    const int c = lane & 7;
#pragma unroll
    for (int j = 0; j < 4; ++j) { const int n = (lane >> 3) + 8 * j; const float* s = scr + (8 * c) * 33 + n;
        uint4 o; o.x = pk2(s[0 * 33], s[1 * 33]); o.y = pk2(s[2 * 33], s[3 * 33]); o.z = pk2(s[4 * 33], s[5 * 33]); o.w = pk2(s[6 * 33], s[7 * 33]);
        *(uint4*)(WT + (size_t)(row_off + n0 + n) * K + k0 + 8 * c) = o; }
    asm volatile("s_waitcnt lgkmcnt(0)" ::: "memory");
}
__device__ __forceinline__ void ph_convert(float* lds, const Args& a, bf16* Win_t, bf16* Wout_t, bf16* W13_t, bf16* W2_t, bf16* Wpool_t, bf16* Wr_t) {
    const int tid = threadIdx.x, lane = tid & 63, wave = tid >> 6;
    float* scr = lds + wave * (64 * 33);
    const int gw = blockIdx.x * 8 + wave, NGW = gridDim.x * 8;
    constexpr int I_IN = 16 * 80, I_OUT = 16 * 32, I_E13 = 16 * 8, I_E2 = 4 * 32, I_PL = 2 * 4;
    constexpr int NITEMS = I_IN + I_OUT + NE * 2 * I_E13 + NE * I_E2 + 4 * I_PL;
    for (int it = gw; it < NITEMS; it += NGW) {
        int r = it;
        if (r < I_IN) { p0_transpose_item((const float*)a.in[I_WIN], D, INC, Win_t, 0, scr, r, lane); continue; } r -= I_IN;
        if (r < I_OUT) { p0_transpose_item((const float*)a.in[I_WOUT], D, D, Wout_t, 0, scr, r, lane); continue; } r -= I_OUT;
        if (r < NE * 2 * I_E13) { const int e = r / (2 * I_E13), q = r % (2 * I_E13), is3 = q / I_E13, item = q % I_E13; const int h = (item % 8) / 4;
            const float* W = (const float*)a.in[is3 ? I_W3 : I_W1] + (size_t)e * D * DE;
            p0_transpose_item(W, D, DE, W13_t, e * 512 + h * 128 + is3 * 128, scr, item, lane); continue; } r -= NE * 2 * I_E13;
        if (r < NE * I_E2) { const int e = r / I_E2, item = r % I_E2; p0_transpose_item((const float*)a.in[I_W2] + (size_t)e * DE * D, DE, D, W2_t, e * 1024, scr, item, lane); continue; } r -= NE * I_E2;
        { const int g = r / I_PL, item = r % I_PL; p0_transpose_item((const float*)a.in[I_WPOOL] + (size_t)g * 128 * 128, 128, 128, Wpool_t, g * 128, scr, item, lane); }
    }
    { const float* wg = (const float*)a.in[I_WGRP]; const float* wr = (const float*)a.in[I_WRT];
      for (int it = blockIdx.x * NTHR + tid; it < 256 * 128; it += gridDim.x * NTHR) { const int j = it >> 7, k0 = (it & 127) * 8; float v[8];
#pragma unroll
          for (int q = 0; q < 8; ++q) v[q] = (j < 4) ? wg[(size_t)(k0 + q) * 4 + j] : (j < 36 ? wr[(size_t)(k0 + q) * 32 + (j - 4)] : 0.f);
          *(uint4*)(Wr_t + (size_t)j * D + k0) = make_uint4(pk2(v[0], v[1]), pk2(v[2], v[3]), pk2(v[4], v[5]), pk2(v[6], v[7])); } }
}

#define LAS __attribute__((address_space(3)))
#define XB_TMO      128
#define XB_XCNT(j)  (256  + 64 * (j))
#define XB_XSUB(j)  (1280 + 64 * (j))
#define XB_XGEN(j)  (2304 + 64 * (j))
#define XB_TOP      3328
#define XB_TOPGEN   3392
#define XCD_BAR_WORDS 3456
#define XB_SPIN_CAP (1u << 22)
__device__ __forceinline__ unsigned xb_ld(unsigned* p)              { return __hip_atomic_load(p, __ATOMIC_RELAXED, __HIP_MEMORY_SCOPE_AGENT); }
__device__ __forceinline__ unsigned xb_add(unsigned* p, unsigned v) { return __hip_atomic_fetch_add(p, v, __ATOMIC_RELAXED, __HIP_MEMORY_SCOPE_AGENT); }
__device__ __forceinline__ unsigned xb_xcc_id() { return (unsigned)__builtin_amdgcn_s_getreg((3 << 11) | 20) & 0xFu; }
#define XB_SPIN(cond, bar) do { unsigned _sp = 0; while (cond) { __builtin_amdgcn_s_sleep(1); \
    if ((++_sp & 255u) == 0u) { if (xb_ld(&(bar)[XB_TMO])) break; if (_sp > XB_SPIN_CAP) { atomicAdd(&(bar)[XB_TMO], 1u); break; } } } } while (0)
struct XcdBarrier { unsigned* bar; unsigned x; volatile LAS unsigned* st; };
__device__ __forceinline__ XcdBarrier xcd_barrier_post(unsigned* bar, volatile LAS unsigned* st) {
    XcdBarrier b; b.bar = bar; b.x = xb_xcc_id(); b.st = st;
    if (threadIdx.x == 0) (void)xb_add(&bar[XB_XCNT(b.x)], 1u);
    return b;
}
__device__ __forceinline__ void xcd_barrier_complete(unsigned* bar, unsigned x, unsigned& nloc, unsigned& nx) {
    const unsigned G = gridDim.x * gridDim.y * gridDim.z;
    unsigned sum, cnt, mine, sp = 0u;
    for (;;) {
        sum = 0u; cnt = 0u; mine = 0u;
#pragma unroll
        for (unsigned j = 0; j < 16; ++j) { const unsigned c = xb_ld(&bar[XB_XCNT(j)]); sum += c; cnt += (c > 0u) ? 1u : 0u; mine = (j == x) ? c : mine; }
        if (sum == G) break;
        __builtin_amdgcn_s_sleep(1);
        if ((++sp & 255u) == 0u) { if (xb_ld(&bar[XB_TMO])) break; if (sp > XB_SPIN_CAP) { atomicAdd(&bar[XB_TMO], 1u); break; } }
    }
    nloc = mine > 0u ? mine : 1u; nx = cnt > 0u ? cnt : 1u;
}
__device__ __forceinline__ void xcd_barrier(const XcdBarrier& b) {
    asm volatile("s_waitcnt vmcnt(0)" ::: "memory");
    __syncthreads();
    if (threadIdx.x == 0) {
        unsigned* bar = b.bar;
        __builtin_amdgcn_s_waitcnt(0);
        unsigned nloc = b.st[0], nx = b.st[1];
        if (nloc == 0u) { xcd_barrier_complete(bar, b.x, nloc, nx); b.st[0] = nloc; b.st[1] = nx; }
        const unsigned old = xb_add(&bar[XB_XSUB(b.x)], 1u);
        const unsigned gen = old / nloc;
        if (old + 1u == (gen + 1u) * nloc) {
            __builtin_amdgcn_fence(__ATOMIC_RELEASE, "agent");
            asm volatile("s_waitcnt vmcnt(0)" ::: "memory");
            const unsigned og = xb_add(&bar[XB_TOP], 1u);
            const unsigned tg = og / nx;
            if (og + 1u == (tg + 1u) * nx) xb_add(&bar[XB_TOPGEN], 1u);
            else XB_SPIN(xb_ld(&bar[XB_TOPGEN]) == tg, bar);
            __builtin_amdgcn_fence(__ATOMIC_ACQUIRE, "agent");
            xb_add(&bar[XB_XGEN(b.x)], 1u);
            asm volatile("s_waitcnt vmcnt(0)" ::: "memory");
        } else {
            XB_SPIN(xb_ld(&bar[XB_XGEN(b.x)]) == gen, bar);
            __builtin_amdgcn_fence(__ATOMIC_ACQUIRE, "agent");
            asm volatile("s_waitcnt vmcnt(0)" ::: "memory");
        }
    }
    __syncthreads();
}
constexpr int CW_BAR = 1024;

constexpr int LDS_BYTES = 147456;
constexpr int MISC_OFF = LDS_BYTES - 64;
constexpr int N_PHASES = 13;

__global__ void __launch_bounds__(NTHR, 2) mk_fwd(Args args) {
    extern __shared__ __attribute__((aligned(16))) unsigned char lds_raw[];
    float* lds = (float*)lds_raw;
    unsigned char* ws = args.ws;
    const float* x = (const float*)args.in[I_X];
    float* part = (float*)(ws + WS_ADAP); float* ada = (float*)(ws + WS_ADA);
    int* tok_e = (int*)(ws + WS_TOKE); float* tok_w = (float*)(ws + WS_TOKW);
    float2* rot = (float2*)(ws + WS_ROT);
    bf16* U = (bf16*)(ws + WS_U); bf16* PROJ = (bf16*)(ws + WS_PROJ); float* V1 = (float*)(ws + WS_V1);
    float* LOG = (float*)(ws + WS_LOG); bf16* MIX = (bf16*)(ws + WS_MIX); float* Y2 = (float*)(ws + WS_Y2);
    const int lo = args.ph_lo, hi = args.ph_hi;
    volatile LAS unsigned* MISC = (volatile LAS unsigned*)((LAS unsigned char*)lds_raw + MISC_OFF);
    if (threadIdx.x < 16) MISC[threadIdx.x] = 0u;
    __syncthreads();
    XcdBarrier bar; bar.bar = (unsigned*)(ws + WS_CTL) + CW_BAR; bar.x = 0; bar.st = nullptr;
    if (hi - lo > 1) bar = xcd_barrier_post((unsigned*)(ws + WS_CTL) + CW_BAR, MISC);
#define IN(k) (lo <= (k) && (k) < hi)
#define SEAM(k) do { if (IN(k) && IN((k) + 1)) xcd_barrier(bar); } while (0)
    if (IN(0)) { ph_ada_partial(lds, (const float*)args.in[I_C], (const float*)args.in[I_WADA], part); __syncthreads(); ph_rot_table((const int*)args.in[I_POS], rot);
        ph_convert(lds, args, (bf16*)(ws + WS_WIN), (bf16*)(ws + WS_WOUT), (bf16*)(ws + WS_W13), (bf16*)(ws + WS_W2), (bf16*)(ws + WS_WPOOL), (bf16*)(ws + WS_WR)); }
    SEAM(0);
    if (IN(1)) { ph_ada_final_lnmod(lds, x, part, (const float*)args.in[I_BADA], ada, U); }
    SEAM(1);
    if (IN(2)) { pg8::Gemm g{U, (const bf16*)(ws + WS_WIN), T, INC, D, D, D}; pg8::StaticOrder S; S.init(T, INC, (int)gridDim.x, (int)blockIdx.x);
        pg8::EpiBf16<0> E{PROJ, INC, nullptr, 0, 0, 1.f};
        pg8::gemm_phase<pg8::EpiBf16<0>, pg8::StaticOrder, true, true>((PG8_LAS unsigned char*)lds_raw, g, S, E); }
    SEAM(2);
    if (IN(3)) { ph_ret_naive(lds, PROJ, rot, (const float*)args.in[I_GNW], MIX); }
    SEAM(3);
    if (IN(4)) { ph_pool_naive(lds, PROJ, (const float*)args.in[I_WPOOL], (const float*)args.in[I_PSCALE], MIX); }
    SEAM(4);
    if (IN(5)) { pg8::Gemm g{MIX, (const bf16*)(ws + WS_WOUT), T, D, D, D, D}; pg8::StaticOrder S; S.init(T, D, (int)gridDim.x, (int)blockIdx.x);
        pg8::EpiV1f E{x, ada, V1};
        pg8::gemm_phase<pg8::EpiV1f, pg8::StaticOrder, true, true>((PG8_LAS unsigned char*)lds_raw, g, S, E); }
    SEAM(5);
    if (IN(6)) { ph_ln1_ln2mod(V1, (const float*)args.in[I_LN1W], (const float*)args.in[I_LN1B], ada, U); }
    SEAM(6);
    if (IN(7)) { ph_router_naive(lds, U, (const float*)args.in[I_WGRP], (const float*)args.in[I_WRT], LOG); }
    SEAM(7);
    if (IN(8)) { ph_route_hist(lds, LOG, 1, (const float*)args.in[I_BGRP], (const float*)args.in[I_BRT], tok_e, tok_w, (int*)(ws + WS_HIST)); }
    SEAM(8);
    if (IN(9)) { ph_permute(lds, (const int*)(ws + WS_HIST), tok_e, tok_w, U, (int*)(ws + WS_TOKS), (float*)(ws + WS_SLOTW), (int*)(ws + WS_TILEE), (bf16*)(ws + WS_U2S)); }
    SEAM(9);
    if (IN(10)) { pg8::Gemm g{(const bf16*)(ws + WS_U2S), (const bf16*)(ws + WS_W13), MAXSLOT, NE * 512, D, D, D}; pg8::MoeOrder<2> S; S.init((const int*)(ws + WS_TILEE), (int)gridDim.x, (int)blockIdx.x);
        pg8::EpiMoeUp E{(bf16*)(ws + WS_HS), (const float*)(ws + WS_SLOTW)};
        pg8::gemm_phase<pg8::EpiMoeUp, pg8::MoeOrder<2>, true, true>((PG8_LAS unsigned char*)lds_raw, g, S, E); }
    SEAM(10);
    if (IN(11)) { pg8::Gemm g{(const bf16*)(ws + WS_HS), (const bf16*)(ws + WS_W2), MAXSLOT, NE * D, DE, DE, DE}; pg8::MoeOrder<4> S; S.init((const int*)(ws + WS_TILEE), (int)gridDim.x, (int)blockIdx.x);
        pg8::EpiBf16<0> E{(bf16*)(ws + WS_YS), D, nullptr, D, 0, 1.f};
        pg8::gemm_phase<pg8::EpiBf16<0>, pg8::MoeOrder<4>, false, true>((PG8_LAS unsigned char*)lds_raw, g, S, E); }
    SEAM(11);
    if (IN(12)) { ph_final_slots(V1, (const bf16*)(ws + WS_YS), (const int*)(ws + WS_TOKS), ada, (const float*)args.in[I_LN2W], (const float*)args.in[I_LN2B], args.out); }
#undef IN
#undef SEAM
}

extern "C" void kernel_launch(void* const* d_in, const int* in_sizes, int n_in, void* d_out, int out_size, void* d_ws, size_t ws_size, hipStream_t stream) {
    static int grid = 0;
    if (grid == 0) {
        if (n_in != 21 || in_sizes[0] != T * D || out_size != T * D || ws_size < WS_END) { fprintf(stderr, "kernel_launch: unexpected shapes (n_in %d, in0 %d, out %d, ws %zu)\n", n_in, n_in > 0 ? in_sizes[0] : -1, out_size, ws_size); grid = -1; return; }
        if (hipFuncSetAttribute((const void*)mk_fwd, hipFuncAttributeMaxDynamicSharedMemorySize, LDS_BYTES) != hipSuccess) { fprintf(stderr, "kernel_launch: hipFuncSetAttribute failed\n"); grid = -1; return; }
        int dev = 0, cus = 0, per_cu = 0;
        if (hipGetDevice(&dev) != hipSuccess || hipDeviceGetAttribute(&cus, hipDeviceAttributeMultiprocessorCount, dev) != hipSuccess) { grid = -1; return; }
        if (hipOccupancyMaxActiveBlocksPerMultiprocessor(&per_cu, (const void*)mk_fwd, NTHR, LDS_BYTES) != hipSuccess || per_cu < 1) { fprintf(stderr, "kernel_launch: occupancy query says %d blocks per CU\n", per_cu); (void)hipGetLastError(); per_cu = 1; }
        grid = cus;
        if (grid > NWG) grid = NWG;
    }
    if (grid < 0) return;
    Args a{};
    for (int i = 0; i < 21; ++i) a.in[i] = d_in[i];
    a.out = (float*)d_out; a.ws = (unsigned char*)d_ws;
    if (hipMemsetAsync((char*)d_ws + WS_CTL, 0, CTL_ZERO_BYTES, stream) != hipSuccess) { fprintf(stderr, "kernel_launch: hipMemsetAsync failed\n"); return; }
    a.ph_lo = 0; a.ph_hi = N_PHASES; a.li = 0;
    hipLaunchKernelGGL(mk_fwd, dim3(grid), dim3(NTHR), LDS_BYTES, stream, a);
}
```

```cpp
#include <hip/hip_runtime.h>
#include <cstdio>
#include <cstdint>

constexpr int NB = 8, SEQ = 2048, D = 1024, T = NB * SEQ;
constexpr int RW = 512, PW = 512, RH = 4, RD = 128;
constexpr int INC = 2560;
constexpr int NGRP = 4, EPG = 8, NE = 32, DE = 256;
constexpr int ADA = 6 * D;
constexpr float ALPHA = 1.189207115002721f;
constexpr float LN_EPS = 1e-5f;
constexpr int NWG = 256, NTHR = 512;

constexpr size_t MiB = 1u << 20;
constexpr size_t WS_CTL = 0, CTL_ZERO_BYTES = 64 * 1024;
constexpr size_t WS_ADAP = 1 * MiB;
constexpr size_t WS_ADA = 2 * MiB + 512 * 1024;
constexpr size_t WS_TOKE = 3 * MiB;
constexpr size_t WS_TOKW = WS_TOKE + 128 * 1024;
constexpr size_t WS_TOKS = WS_TOKE + 256 * 1024;
constexpr size_t WS_HIST = WS_TOKE + 384 * 1024;
constexpr size_t WS_SLOTW = WS_TOKE + 512 * 1024;
constexpr size_t WS_TILEE = WS_TOKE + 768 * 1024;
constexpr size_t WS_ROT = 4 * MiB;
constexpr size_t WS_WR = 12 * MiB;
constexpr size_t WS_WPOOL = 12 * MiB + 512 * 1024;
constexpr size_t WS_WIN = 13 * MiB;
constexpr size_t WS_WOUT = 18 * MiB;
constexpr size_t WS_W13 = 20 * MiB;
constexpr size_t WS_W2 = 52 * MiB;
constexpr size_t WS_U = 68 * MiB;
constexpr size_t WS_PROJ = 100 * MiB;
constexpr size_t WS_V1 = 100 * MiB;
constexpr size_t WS_LOG = 180 * MiB;
constexpr size_t WS_KV = 180 * MiB;
constexpr size_t WS_MIX = 212 * MiB;
constexpr size_t WS_Y2 = 164 * MiB;
constexpr size_t WS_U2S = 164 * MiB;
constexpr size_t WS_HS = 68 * MiB;
constexpr size_t WS_YS = 164 * MiB;
constexpr int MAXTILES = 160, MAXSLOT = MAXTILES * 256;
constexpr size_t WS_END = 256 * MiB;

typedef unsigned short bf16;
__device__ __forceinline__ unsigned f2bf(float f) { unsigned u = __builtin_bit_cast(unsigned, f); return (u + 0x7fffu + ((u >> 16) & 1u)) >> 16; }
__device__ __forceinline__ unsigned pk2(float lo, float hi) { return f2bf(lo) | (f2bf(hi) << 16); }
__device__ __forceinline__ float bflo(unsigned u) { return __builtin_bit_cast(float, u << 16); }
__device__ __forceinline__ float bfhi(unsigned u) { return __builtin_bit_cast(float, u & 0xffff0000u); }
__device__ __forceinline__ float bf2f(bf16 h) { return __builtin_bit_cast(float, (unsigned)h << 16); }
__device__ __forceinline__ float silu_f(float x) { return x / (1.0f + expf(-x)); }
__device__ __forceinline__ float wave_sum(float v) {
#pragma unroll
    for (int o = 1; o < 64; o <<= 1) v += __shfl_xor(v, o);
    return v;
}

__device__ __forceinline__ int tid_fresh() { int t = threadIdx.x; asm volatile("" : "+v"(t)); return t; }
#ifndef USE_NAIVE_RET
#define USE_NAIVE_RET 0
#endif
#ifndef USE_NAIVE_POOL
#define USE_NAIVE_POOL 0
#endif
struct Args { const void* in[21]; float* out; unsigned char* ws; int ph_lo, ph_hi, li, pad; };
enum { I_X = 0, I_C, I_POS, I_WADA, I_BADA, I_WIN, I_GNW, I_WPOOL, I_PSCALE, I_WOUT, I_LN1W, I_LN1B, I_WGRP, I_BGRP, I_WRT, I_BRT, I_W1, I_W3, I_W2, I_LN2W, I_LN2B };

template <class Epi>
__device__ __forceinline__ void naive_gemm(float* lds, const bf16* A, int lda, const float* W, int ldw, int M, int N, int K, const Epi& epi) {
    float* As = lds;
    float* Ws = lds + 16 * 132;
    const int tid = tid_fresh(), tx = tid & 31, ty = tid >> 5;
    const int ntn = N / 128, ntiles = (M / 128) * ntn;
    for (int tile = blockIdx.x; tile < ntiles; tile += gridDim.x) {
        const int tm = tile / ntn, tn = tile % ntn, row0 = tm * 128, col0 = tn * 128;
        float acc[8][4];
#pragma unroll
        for (int i = 0; i < 8; ++i)
#pragma unroll
            for (int j = 0; j < 4; ++j) acc[i][j] = 0.f;
        for (int k0 = 0; k0 < K; k0 += 16) {
            { const int r = tid >> 2, kq = (tid & 3) * 4; const uint2 raw = *(const uint2*)(A + (size_t)(row0 + r) * lda + k0 + kq);
              As[(kq + 0) * 132 + r] = bflo(raw.x); As[(kq + 1) * 132 + r] = bfhi(raw.x); As[(kq + 2) * 132 + r] = bflo(raw.y); As[(kq + 3) * 132 + r] = bfhi(raw.y); }
            { const int k = tid >> 5, n4 = (tid & 31) * 4; *(float4*)(Ws + k * 132 + n4) = *(const float4*)(W + (size_t)(k0 + k) * ldw + col0 + n4); }
            __syncthreads();
#pragma unroll
            for (int k = 0; k < 16; ++k) {
                const float4 a0 = *(const float4*)(As + k * 132 + ty * 8), a1 = *(const float4*)(As + k * 132 + ty * 8 + 4);
                const float4 w = *(const float4*)(Ws + k * 132 + tx * 4);
                const float av[8] = {a0.x, a0.y, a0.z, a0.w, a1.x, a1.y, a1.z, a1.w};
#pragma unroll
                for (int i = 0; i < 8; ++i) { acc[i][0] += av[i] * w.x; acc[i][1] += av[i] * w.y; acc[i][2] += av[i] * w.z; acc[i][3] += av[i] * w.w; }
            }
            __syncthreads();
        }
#pragma unroll
        for (int i = 0; i < 8; ++i) epi(row0 + ty * 8 + i, col0 + tx * 4, make_float4(acc[i][0], acc[i][1], acc[i][2], acc[i][3]));
    }
}

__device__ __forceinline__ void ph_ada_partial(float* lds, const float* c, const float* w_ada, float* part) {
    const int w = blockIdx.x, tid = tid_fresh();
    if (w >= 96) return;
    const int cb = w % 12, kr = w / 12, c4 = tid & 127, ks = tid >> 7;
    float* cact = lds;
    float4* red = (float4*)(lds + 1024);
    for (int i = tid; i < 1024; i += NTHR) { const int b = i >> 7, kk = i & 127; cact[i] = silu_f(c[b * D + kr * 128 + kk]); }
    __syncthreads();
    float4 acc[8];
#pragma unroll
    for (int b = 0; b < 8; ++b) acc[b] = make_float4(0.f, 0.f, 0.f, 0.f);
    const int col = (cb * 128 + c4) * 4;
    for (int kk = 0; kk < 32; ++kk) {
        const int kl = ks * 32 + kk;
        const float4 wv = *(const float4*)(w_ada + (size_t)(kr * 128 + kl) * ADA + col);
#pragma unroll
        for (int b = 0; b < 8; ++b) { const float a = cact[b * 128 + kl]; acc[b].x += a * wv.x; acc[b].y += a * wv.y; acc[b].z += a * wv.z; acc[b].w += a * wv.w; }
    }
#pragma unroll
    for (int b = 0; b < 8; ++b) red[(ks * 8 + b) * 128 + c4] = acc[b];
    __syncthreads();
    for (int i = tid; i < 1024; i += NTHR) {
        const int b = i >> 7, cc = i & 127;
        float4 s = red[(0 * 8 + b) * 128 + cc];
#pragma unroll
        for (int q = 1; q < 4; ++q) { const float4 v = red[(q * 8 + b) * 128 + cc]; s.x += v.x; s.y += v.y; s.z += v.z; s.w += v.w; }
        *(float4*)(part + ((size_t)kr * 8 + b) * ADA + (cb * 128 + cc) * 4) = s;
    }
}
__device__ __forceinline__ void ph_rot_table(const int* pos, float2* rot) {
    const int gt = blockIdx.x * NTHR + tid_fresh(), GT = gridDim.x * NTHR;
    for (int idx = gt; idx < T * 64; idx += GT) {
        const int t = idx >> 6, i = idx & 63;
        const double inv = exp2(-(double)i * (13.287712379549449 / 64.0));
        const double ang = (double)pos[t] * inv;
        const double k = rint(ang * 0.15915494309189535);
        double r = fma(-k, 6.283185307179586, ang); r = fma(-k, 2.4492935982947064e-16, r);
        const float rf = (float)r;
        rot[idx] = make_float2(cosf(rf), sinf(rf));
    }
}
__device__ __forceinline__ void ph_ada_final_lnmod(float* lds, const float* x, const float* part, const float* b_ada, float* ada, bf16* U) {
    const int w = blockIdx.x, tid = tid_fresh(), lane = tid & 63, wave = tid >> 6, b = w >> 5;
    float* sh1 = lds; float* sc1 = lds + 1024;
    for (int j = tid; j < 2048; j += NTHR) { float s = b_ada[j]; for (int kr = 0; kr < 8; ++kr) s += part[((size_t)kr * 8 + b) * ADA + j]; if (j < 1024) sh1[j] = s; else sc1[j - 1024] = 1.0f + s; }
    { const int j0 = (w & 31) * 192; for (int j = tid; j < 192; j += NTHR) { float s = b_ada[j0 + j]; for (int kr = 0; kr < 8; ++kr) s += part[((size_t)kr * 8 + b) * ADA + j0 + j]; ada[(size_t)b * ADA + j0 + j] = s; } }
    __syncthreads();
    for (int i = 0; i < 8; ++i) {
        const int row = w * 64 + wave * 8 + i;
        const float4* xr = (const float4*)(x + (size_t)row * D) + lane;
        float4 v[4]; float s = 0.f;
#pragma unroll
        for (int j = 0; j < 4; ++j) { v[j] = xr[64 * j]; s += (v[j].x + v[j].y) + (v[j].z + v[j].w); }
        const float mean = wave_sum(s) * (1.f / D); float s2 = 0.f;
#pragma unroll
        for (int j = 0; j < 4; ++j) { v[j].x -= mean; v[j].y -= mean; v[j].z -= mean; v[j].w -= mean; s2 += (v[j].x * v[j].x + v[j].y * v[j].y) + (v[j].z * v[j].z + v[j].w * v[j].w); }
        const float rstd = 1.f / sqrtf(wave_sum(s2) * (1.f / D) + LN_EPS);
        uint2* o = (uint2*)(U + (size_t)row * D) + lane;
#pragma unroll
        for (int j = 0; j < 4; ++j) { const float4 sc = *(const float4*)(sc1 + 4 * lane + 256 * j), sh = *(const float4*)(sh1 + 4 * lane + 256 * j);
            o[64 * j] = make_uint2(pk2(v[j].x * rstd * sc.x + sh.x, v[j].y * rstd * sc.y + sh.y), pk2(v[j].z * rstd * sc.z + sh.z, v[j].w * rstd * sc.w + sh.w)); }
    }
}
__device__ __forceinline__ void ph_ret_naive(float* lds, const bf16* proj, const float2* rot, const float* gnw, bf16* mix) {
    const int w = blockIdx.x, tid = tid_fresh();
    if (w >= 32) return;
    const int b = w >> 2, h = w & 3, e = tid & 127, dg = tid >> 7;
    const float gamma = 1.0f - exp2f(-5.0f - (float)h);
    float* Q = lds;
    float* Kk = lds + 4096;
    float* V = lds + 8192;
    float* red = lds + 12288;
    float Sx[32];
#pragma unroll
    for (int i = 0; i < 32; ++i) Sx[i] = 0.f;
    for (int t0 = 0; t0 < SEQ; t0 += 32) {
        __syncthreads();
        for (int it = tid; it < 32 * 64; it += NTHR) {
            const int r = it >> 6, i = it & 63; const size_t row = (size_t)b * SEQ + t0 + r;
            const float2 cs = rot[row * 64 + i];
            const bf16* pr = proj + row * INC;
            const float q1 = bf2f(pr[h * 128 + i]), q2 = bf2f(pr[h * 128 + 64 + i]);
            const float k1 = bf2f(pr[512 + h * 128 + i]), k2 = bf2f(pr[512 + h * 128 + 64 + i]);
            Q[r * 128 + i] = q1 * cs.x - q2 * cs.y; Q[r * 128 + 64 + i] = q1 * cs.y + q2 * cs.x;
            Kk[r * 128 + i] = (k1 * cs.x - k2 * cs.y) * 0.08838834764831845f; Kk[r * 128 + 64 + i] = (k1 * cs.y + k2 * cs.x) * 0.08838834764831845f;
            V[r * 128 + i] = bf2f(pr[1024 + h * 128 + i]); V[r * 128 + 64 + i] = bf2f(pr[1024 + h * 128 + 64 + i]);
        }
        __syncthreads();
        for (int r = 0; r < 32; ++r) {
            const float ve = V[r * 128 + e]; float o = 0.f;
#pragma unroll
            for (int dd = 0; dd < 32; ++dd) { const int d = dg * 32 + dd; Sx[dd] = gamma * Sx[dd] + Kk[r * 128 + d] * ve; o += Q[r * 128 + d] * Sx[dd]; }
            red[(r * 4 + dg) * 128 + e] = o;
        }
        __syncthreads();
        { const int lane = tid & 63, wave = tid >> 6;
          for (int rr = 0; rr < 4; ++rr) { const int r = wave * 4 + rr; const size_t row = (size_t)b * SEQ + t0 + r;
              float v0 = 0.f, v1 = 0.f;
#pragma unroll
              for (int q = 0; q < 4; ++q) { v0 += red[(r * 4 + q) * 128 + lane]; v1 += red[(r * 4 + q) * 128 + 64 + lane]; }
              const float mean = wave_sum(v0 + v1) * (1.f / 128.f); v0 -= mean; v1 -= mean;
              const float rstd = 1.f / sqrtf(wave_sum(v0 * v0 + v1 * v1) * (1.f / 128.f) + LN_EPS);
              const bf16* pr = proj + row * INC + 1536 + h * 128;
              const float g0 = bf2f(pr[lane]), g1 = bf2f(pr[64 + lane]);
              bf16* mo = mix + row * D + h * 128;
              mo[lane] = (bf16)f2bf(silu_f(g0) * (v0 * rstd * gnw[h * 128 + lane])); mo[64 + lane] = (bf16)f2bf(silu_f(g1) * (v1 * rstd * gnw[h * 128 + 64 + lane])); } }
    }
}
__device__ __forceinline__ void ph_pool_naive(float* lds, const bf16* proj, const float* w_pool, const float* pscale, bf16* mix) {
    const int tid = tid_fresh();
    float* P = lds;
    for (int unit = blockIdx.x; unit < 256 * 4; unit += gridDim.x) {
        const int rb = unit >> 2, g = unit & 3, win = 2 << g, row0 = rb * 64;
        __syncthreads();
        for (int it = tid; it < 64 * 128; it += NTHR) {
            const int r = it >> 7, cc = it & 127; const int row = row0 + r, s = row & (SEQ - 1);
            const int cnt = (s + 1 < win) ? (s + 1) : win;
            float sum = 0.f;
            for (int j = 0; j < cnt; ++j) sum += bf2f(proj[(size_t)(row - j) * INC + 2048 + g * 128 + cc]);
            P[it] = sum / (float)cnt - bf2f(proj[(size_t)row * INC + 2048 + g * 128 + cc]);
        }
        __syncthreads();
        const int d = tid & 127, rg = tid >> 7;
        float acc[16];
#pragma unroll
        for (int i = 0; i < 16; ++i) acc[i] = 0.f;
        for (int cc = 0; cc < 128; ++cc) { const float wv = w_pool[((size_t)g * 128 + cc) * 128 + d];
#pragma unroll
            for (int i = 0; i < 16; ++i) acc[i] += P[(rg * 16 + i) * 128 + cc] * wv; }
        const float ps = pscale[g * 128 + d];
#pragma unroll
        for (int i = 0; i < 16; ++i) mix[(size_t)(row0 + rg * 16 + i) * D + 512 + g * 128 + d] = (bf16)f2bf(acc[i] * ps);
    }
}
__device__ __forceinline__ void ph_ln1_ln2mod(float* V1, const float* ln1w, const float* ln1b, const float* ada, bf16* U2) {
    const int tid = tid_fresh(), lane = tid & 63, wave = tid >> 6;
    for (int row = blockIdx.x * 8 + wave; row < T; row += gridDim.x * 8) {
        const int b = row / SEQ;
        float4* xr = (float4*)(V1 + (size_t)row * D) + lane;
        float4 v[4]; float s = 0.f;
#pragma unroll
        for (int j = 0; j < 4; ++j) { v[j] = xr[64 * j]; s += (v[j].x + v[j].y) + (v[j].z + v[j].w); }
        float mean = wave_sum(s) * (1.f / D); float s2 = 0.f;
#pragma unroll
        for (int j = 0; j < 4; ++j) { v[j].x -= mean; v[j].y -= mean; v[j].z -= mean; v[j].w -= mean; s2 += (v[j].x * v[j].x + v[j].y * v[j].y) + (v[j].z * v[j].z + v[j].w * v[j].w); }
        float rstd = 1.f / sqrtf(wave_sum(s2) * (1.f / D) + LN_EPS);
        s = 0.f;
#pragma unroll
        for (int j = 0; j < 4; ++j) { const float4 lw = *((const float4*)ln1w + lane + 64 * j), lb = *((const float4*)ln1b + lane + 64 * j);
            v[j].x = v[j].x * rstd * lw.x + lb.x; v[j].y = v[j].y * rstd * lw.y + lb.y; v[j].z = v[j].z * rstd * lw.z + lb.z; v[j].w = v[j].w * rstd * lw.w + lb.w;
            xr[64 * j] = v[j]; s += (v[j].x + v[j].y) + (v[j].z + v[j].w); }
        mean = wave_sum(s) * (1.f / D); s2 = 0.f;
#pragma unroll
        for (int j = 0; j < 4; ++j) { v[j].x -= mean; v[j].y -= mean; v[j].z -= mean; v[j].w -= mean; s2 += (v[j].x * v[j].x + v[j].y * v[j].y) + (v[j].z * v[j].z + v[j].w * v[j].w); }
        rstd = 1.f / sqrtf(wave_sum(s2) * (1.f / D) + LN_EPS);
        const float* sh2 = ada + (size_t)b * ADA + 3 * D; const float* sc2 = ada + (size_t)b * ADA + 4 * D;
        uint2* o = (uint2*)(U2 + (size_t)row * D) + lane;
#pragma unroll
        for (int j = 0; j < 4; ++j) { const float4 sc = *((const float4*)sc2 + lane + 64 * j), sh = *((const float4*)sh2 + lane + 64 * j);
            o[64 * j] = make_uint2(pk2(v[j].x * rstd * (1.f + sc.x) + sh.x, v[j].y * rstd * (1.f + sc.y) + sh.y), pk2(v[j].z * rstd * (1.f + sc.z) + sh.z, v[j].w * rstd * (1.f + sc.w) + sh.w)); }
    }
}
__device__ __forceinline__ void ph_router_naive(float* lds, const bf16* U2, const float* wg, const float* wr, float* logits) {
    const int tid = tid_fresh(), tl = tid >> 3, jg = tid & 7;
    float* Wl = lds;
    for (int blk = blockIdx.x; blk < T / 64; blk += gridDim.x) {
        const int t = blk * 64 + tl;
        float acc[5] = {0.f, 0.f, 0.f, 0.f, 0.f};
        for (int kh = 0; kh < 2; ++kh) {
            __syncthreads();
            for (int it = tid; it < 512 * 36; it += NTHR) { const int k = it / 36, j = it % 36; Wl[it] = (j < 4) ? wg[(size_t)(kh * 512 + k) * 4 + j] : wr[(size_t)(kh * 512 + k) * 32 + (j - 4)]; }
            __syncthreads();
            for (int k = 0; k < 512; ++k) { const float u = bf2f(U2[(size_t)t * D + kh * 512 + k]);
#pragma unroll
                for (int i = 0; i < 5; ++i) { const int j = jg + 8 * i; if (j < 36) acc[i] += u * Wl[k * 36 + j]; } }
        }
#pragma unroll
        for (int i = 0; i < 5; ++i) { const int j = jg + 8 * i; if (j < 36) logits[(size_t)t * 64 + j] = acc[i]; }
    }
}
__device__ __forceinline__ void ph_route(const float* logits, int npart, const float* bg, const float* br, int* tok_e, float* tok_w) {
    const int gt = blockIdx.x * NTHR + tid_fresh(), GT = gridDim.x * NTHR;
    for (int t = gt; t < T; t += GT) {
        float gl[4];
#pragma unroll
        for (int j = 0; j < 4; ++j) { float s = bg[j]; for (int p = 0; p < npart; ++p) s += logits[((size_t)p * T + t) * 64 + j]; gl[j] = s; }
        int gi = 0; float gm = gl[0];
#pragma unroll
        for (int j = 1; j < 4; ++j) if (gl[j] > gm) { gm = gl[j]; gi = j; }
        float den = 0.f;
#pragma unroll
        for (int j = 0; j < 4; ++j) den += expf(gl[j] - gm);
        const float gprob = 1.0f / den;
        float el[8];
#pragma unroll
        for (int i = 0; i < 8; ++i) { float s = 0.f; for (int p = 0; p < npart; ++p) s += logits[((size_t)p * T + t) * 64 + 4 + gi * 8 + i]; el[i] = s + br[gi * 8 + i]; }
        int i0 = 0; float v0 = el[0];
#pragma unroll
        for (int i = 1; i < 8; ++i) if (el[i] > v0) { v0 = el[i]; i0 = i; }
        int i1 = -1; float v1 = 0.f;
#pragma unroll
        for (int i = 0; i < 8; ++i) if (i != i0 && (i1 < 0 || el[i] > v1)) { v1 = el[i]; i1 = i; }
        const float ex = expf(v1 - v0), inv = 1.0f / (1.0f + ex);
        tok_e[2 * t] = gi * 8 + i0; tok_e[2 * t + 1] = gi * 8 + i1;
        tok_w[2 * t] = gprob * inv; tok_w[2 * t + 1] = gprob * ex * inv;
    }
}
__device__ __forceinline__ void ph_moe_naive(float* lds, const bf16* U2, const int* tok_e, const float* tok_w, const float* w1, const float* w3, const float* w2, float* Y2) {
    const int tid = tid_fresh();
    float* u = lds;
    float* pa = lds + 1024;
    float* pb = lds + 1536;
    float* hh = lds + 2048;
    for (int t = blockIdx.x; t < T; t += gridDim.x) {
        __syncthreads();
        for (int i = tid; i < D; i += NTHR) u[i] = bf2f(U2[(size_t)t * D + i]);
        float y0 = 0.f, y1 = 0.f;
        for (int k = 0; k < 2; ++k) {
            const int e = tok_e[2 * t + k]; const float wgt = tok_w[2 * t + k];
            __syncthreads();
            { const int f = tid & 255, hf = tid >> 8; const float* p1 = w1 + ((size_t)e * D + hf * 512) * DE + f; const float* p3 = w3 + ((size_t)e * D + hf * 512) * DE + f;
              float a = 0.f, bq = 0.f;
              for (int d = 0; d < 512; ++d) { const float uv = u[hf * 512 + d]; a += uv * p1[(size_t)d * DE]; bq += uv * p3[(size_t)d * DE]; }
              pa[hf * 256 + f] = a; pb[hf * 256 + f] = bq; }
            __syncthreads();
            if (tid < 256) { const float a = pa[tid] + pa[256 + tid], bq = pb[tid] + pb[256 + tid]; hh[tid] = silu_f(a) * bq * wgt; }
            __syncthreads();
            { const float* p2 = w2 + (size_t)e * DE * D + tid;
              for (int f = 0; f < 256; ++f) { const float hv = hh[f]; y0 += hv * p2[(size_t)f * D]; y1 += hv * p2[(size_t)f * D + 512]; } }
        }
        Y2[(size_t)t * D + tid] = y0; Y2[(size_t)t * D + 512 + tid] = y1;
    }
}
__device__ __forceinline__ void ph_final(const float* X1, const float* Y2, const float* ada, const float* ln2w, const float* ln2b, float* out) {
    const int tid = tid_fresh(), lane = tid & 63, wave = tid >> 6;
    for (int row = blockIdx.x * 8 + wave; row < T; row += gridDim.x * 8) {
        const int b = row / SEQ;
        const float4* xr = (const float4*)(X1 + (size_t)row * D) + lane; const float4* yr = (const float4*)(Y2 + (size_t)row * D) + lane;
        const float4* g2 = (const float4*)(ada + (size_t)b * ADA + 5 * D) + lane;
        float4 v[4]; float s = 0.f;
#pragma unroll
        for (int j = 0; j < 4; ++j) { const float4 xv = xr[64 * j], yv = yr[64 * j], gv = g2[64 * j];
            v[j].x = ALPHA * xv.x + gv.x * yv.x; v[j].y = ALPHA * xv.y + gv.y * yv.y; v[j].z = ALPHA * xv.z + gv.z * yv.z; v[j].w = ALPHA * xv.w + gv.w * yv.w; s += (v[j].x + v[j].y) + (v[j].z + v[j].w); }
        const float mean = wave_sum(s) * (1.f / D); float s2 = 0.f;
#pragma unroll
        for (int j = 0; j < 4; ++j) { v[j].x -= mean; v[j].y -= mean; v[j].z -= mean; v[j].w -= mean; s2 += (v[j].x * v[j].x + v[j].y * v[j].y) + (v[j].z * v[j].z + v[j].w * v[j].w); }
        const float rstd = 1.f / sqrtf(wave_sum(s2) * (1.f / D) + LN_EPS);
        float4* o = (float4*)(out + (size_t)row * D) + lane;
#pragma unroll
        for (int j = 0; j < 4; ++j) { const float4 lw = *((const float4*)ln2w + lane + 64 * j), lb = *((const float4*)ln2b + lane + 64 * j);
            o[64 * j] = make_float4(v[j].x * rstd * lw.x + lb.x, v[j].y * rstd * lw.y + lb.y, v[j].z * rstd * lw.z + lb.z, v[j].w * rstd * lw.w + lb.w); }
    }
}


__device__ __forceinline__ void ph_route_hist(float* lds, const float* logits, int npart, const float* bg, const float* br, int* tok_e, float* tok_w, int* hist) {
    const int tid = tid_fresh(); int* h = (int*)lds;
    for (int blk = blockIdx.x; blk < T / 64; blk += gridDim.x) {
        __syncthreads();
        if (tid < 32) h[tid] = 0;
        __syncthreads();
        if (tid < 64) {
            const int t = blk * 64 + tid;
            float gl[4];
#pragma unroll
            for (int j = 0; j < 4; ++j) { float s = bg[j]; for (int p = 0; p < npart; ++p) s += logits[((size_t)p * T + t) * 64 + j]; gl[j] = s; }
            int gi = 0; float gm = gl[0];
#pragma unroll
            for (int j = 1; j < 4; ++j) if (gl[j] > gm) { gm = gl[j]; gi = j; }
            float den = 0.f;
#pragma unroll
            for (int j = 0; j < 4; ++j) den += expf(gl[j] - gm);
            const float gprob = 1.0f / den;
            float el[8];
#pragma unroll
            for (int i = 0; i < 8; ++i) { float s = 0.f; for (int p = 0; p < npart; ++p) s += logits[((size_t)p * T + t) * 64 + 4 + gi * 8 + i]; el[i] = s + br[gi * 8 + i]; }
            int i0 = 0; float v0 = el[0];
#pragma unroll
            for (int i = 1; i < 8; ++i) if (el[i] > v0) { v0 = el[i]; i0 = i; }
            int i1 = -1; float v1 = 0.f;
#pragma unroll
            for (int i = 0; i < 8; ++i) if (i != i0 && (i1 < 0 || el[i] > v1)) { v1 = el[i]; i1 = i; }
            const float ex = expf(v1 - v0), inv = 1.0f / (1.0f + ex);
            tok_e[2 * t] = gi * 8 + i0; tok_e[2 * t + 1] = gi * 8 + i1;
            tok_w[2 * t] = gprob * inv; tok_w[2 * t + 1] = gprob * ex * inv;
            atomicAdd(&h[gi * 8 + i0], 1); atomicAdd(&h[gi * 8 + i1], 1);
        }
        __syncthreads();
        if (tid < 32) hist[blk * 32 + tid] = h[tid];
    }
}
__device__ __forceinline__ void ph_permute(float* lds, const int* hist, const int* tok_e, const float* tok_w, const bf16* U2, int* tok_slot, float* slot_w, int* tile_e, bf16* U2s) {
    const int tid = tid_fresh(), lane = tid & 63, wave = tid >> 6;
    int* cnt = (int*)lds; int* pre = cnt + 32; int* base = cnt + 64; int* ee = cnt + 128; int* ss = cnt + 256;
    for (int blk = blockIdx.x; blk < T / 64; blk += gridDim.x) {
        __syncthreads();
        if (tid < 32) { int c = 0, p = 0; for (int w = 0; w < T / 64; ++w) { const int v = hist[w * 32 + tid]; c += v; if (w < blk) p += v; } cnt[tid] = c; pre[tid] = p; }
        if (tid >= 64 && tid < 192) ee[tid - 64] = tok_e[blk * 128 + (tid - 64)];
        __syncthreads();
        if (tid == 0) { int b = 0; for (int e = 0; e < 32; ++e) { base[e] = b; b += (cnt[e] + 255) & ~255; } base[32] = b; }
        __syncthreads();
        if (tid < 128) { const int e = ee[tid]; int rank = 0; for (int j = 0; j < tid; ++j) rank += (ee[j] == e) ? 1 : 0;
            const int slot = base[e] + pre[e] + rank; ss[tid] = slot; tok_slot[blk * 128 + tid] = slot; slot_w[slot] = tok_w[blk * 128 + tid]; }
        if (blk == 0 && tid >= 256 && tid < 256 + 32) { const int e = tid - 256; const int t0 = base[e] >> 8, t1 = base[e + 1] >> 8; for (int q = t0; q < t1; ++q) tile_e[q] = e; if (e == 0) tile_e[MAXTILES] = base[32] >> 8; }
        __syncthreads();
        for (int i = wave; i < 128; i += 8) { const int t = blk * 64 + (i >> 1); const uint4* s = (const uint4*)(U2 + (size_t)t * D); uint4* d = (uint4*)(U2s + (size_t)ss[i] * D);
            d[lane] = s[lane]; d[lane + 64] = s[lane + 64]; }
    }
}
__device__ __forceinline__ void ph_final_slots(const float* X1, const bf16* Ys, const int* tok_slot, const float* ada, const float* ln2w, const float* ln2b, float* out) {
    const int tid = tid_fresh(), lane = tid & 63, wave = tid >> 6;
    for (int row = blockIdx.x * 8 + wave; row < T; row += gridDim.x * 8) {
        const int b = row / SEQ; const int s0 = tok_slot[2 * row], s1 = tok_slot[2 * row + 1];
        const float4* xr = (const float4*)(X1 + (size_t)row * D) + lane;
        const uint2* y0 = (const uint2*)(Ys + (size_t)s0 * D) + lane; const uint2* y1 = (const uint2*)(Ys + (size_t)s1 * D) + lane;
        const float4* g2 = (const float4*)(ada + (size_t)b * ADA + 5 * D) + lane;
        float4 v[4]; float s = 0.f;
#pragma unroll
        for (int j = 0; j < 4; ++j) { const float4 xv = xr[64 * j], gv = g2[64 * j]; const uint2 a = y0[64 * j], c = y1[64 * j];
            v[j].x = ALPHA * xv.x + gv.x * (bflo(a.x) + bflo(c.x)); v[j].y = ALPHA * xv.y + gv.y * (bfhi(a.x) + bfhi(c.x));
            v[j].z = ALPHA * xv.z + gv.z * (bflo(a.y) + bflo(c.y)); v[j].w = ALPHA * xv.w + gv.w * (bfhi(a.y) + bfhi(c.y)); s += (v[j].x + v[j].y) + (v[j].z + v[j].w); }
        const float mean = wave_sum(s) * (1.f / D); float s2 = 0.f;
#pragma unroll
        for (int j = 0; j < 4; ++j) { v[j].x -= mean; v[j].y -= mean; v[j].z -= mean; v[j].w -= mean; s2 += (v[j].x * v[j].x + v[j].y * v[j].y) + (v[j].z * v[j].z + v[j].w * v[j].w); }
        const float rstd = 1.f / sqrtf(wave_sum(s2) * (1.f / D) + LN_EPS);
        float4* o = (float4*)(out + (size_t)row * D) + lane;
#pragma unroll
        for (int j = 0; j < 4; ++j) { const float4 lw = *((const float4*)ln2w + lane + 64 * j), lb = *((const float4*)ln2b + lane + 64 * j);
            o[64 * j] = make_float4(v[j].x * rstd * lw.x + lb.x, v[j].y * rstd * lw.y + lb.y, v[j].z * rstd * lw.z + lb.z, v[j].w * rstd * lw.w + lb.w); }
    }
}

struct EpiStoreBf16 { bf16* O; int ldc; __device__ __forceinline__ void operator()(int row, int col, float4 a) const { *(uint2*)(O + (size_t)row * ldc + col) = make_uint2(pk2(a.x, a.y), pk2(a.z, a.w)); } };
struct EpiV1 { const float* x; const float* ada; float* V1;
    __device__ __forceinline__ void operator()(int row, int col, float4 a) const { const int b = row / SEQ; const float4 xv = *(const float4*)(x + (size_t)row * D + col), g = *(const float4*)(ada + (size_t)b * ADA + 2 * D + col);
        *(float4*)(V1 + (size_t)row * D + col) = make_float4(ALPHA * xv.x + g.x * a.x, ALPHA * xv.y + g.y * a.y, ALPHA * xv.z + g.z * a.z, ALPHA * xv.w + g.w * a.w); } };


namespace pg8 {
#define PG8_LAS __attribute__((address_space(3)))
typedef unsigned short bf16_t;
typedef short bf16x8 __attribute__((ext_vector_type(8)));
typedef float f32x4 __attribute__((ext_vector_type(4)));
typedef unsigned u32x4 __attribute__((ext_vector_type(4)));
constexpr int BM = 256, BK = 64, HALF = 128, HTB = HALF * BK * 2  , STAGE_BYTES = 8 * HTB, NXCD = 8, WGM = 8;

__host__ __device__ __forceinline__ int lds_byte(int r, int c) { const int st = (r >> 4) * 2 + (c >> 5), rr = r & 15, cc = c & 31, ob = rr * 64 + cc * 2; return st * 1024 + (ob ^ (((ob >> 9) & 1) << 5)); }
__host__ __device__ __forceinline__ void stage_rc(int b, int& R, int& C) { const int st = b / 1024, sb = b % 1024, swz = sb ^ (((sb >> 9) & 1) << 5); R = (st >> 1) * 16 + swz / 64; C = (st & 1) * 32 + (swz % 64) / 2; }
__host__ __device__ __forceinline__ int perm32(int rho) { const int n = rho >> 4, i = rho & 15; return 8 * (i >> 2) + 4 * n + (i & 3); }

struct Unit { int pm, pn, ka; };
struct Gemm { const bf16_t* A; const bf16_t* Bt; int M, N, K, lda, ldb; };

struct StaticOrder {
    int nM, nN, nwg, G, c;
    __host__ __device__ void init(int M, int N, int G_, int c_) { nM = M / BM; nN = N / BM; nwg = nM * nN; G = G_; c = c_; }
    __host__ __device__ bool next(int i, Unit& u) const {
        const long L = (long)i * G + c; if (L >= nwg) return false;
        int wgid = (int)L; { const int q = nwg / NXCD, r = nwg % NXCD, xcd = wgid % NXCD, off = wgid / NXCD; wgid = (xcd < r ? xcd * (q + 1) : r * (q + 1) + (xcd - r) * q) + off; }
        const int nig = WGM * nN, gid = wgid / nig, fm = gid * WGM, gsz = (nM - fm) < WGM ? (nM - fm) : WGM;
        u.pm = fm + ((wgid % nig) % gsz); u.pn = (wgid % nig) / gsz; u.ka = 0; return true;
    }
    __device__ __forceinline__ void a_ready(const Unit&) const {}
    __device__ __forceinline__ void done(const Unit&) const {}
};

__device__ __forceinline__ unsigned cvt_pk_bf16(float lo, float hi) { unsigned r; asm volatile("v_cvt_pk_bf16_f32 %0, %1, %2" : "=v"(r) : "v"(lo), "v"(hi)); return r; }
typedef float f32x2 __attribute__((ext_vector_type(2)));
__device__ __forceinline__ f32x2 gelu_pk(f32x2 v) { return v; }
template <int ACT  > struct EpiBf16 {
    static constexpr bool PERM = true, AFTER_DRAIN = false; static_assert(ACT == 0 || ACT == 1, "EpiBf16: ACT is 0 (none) or 1 (gelu_pk)");
    bf16_t* O; int ldc; const float* bias; int split_cols; size_t split_stride; float scale0;
    __device__ __forceinline__ void operator()(const f32x4 (&acc)[2][2][4][2], const Unit& u, int wr, int wc, int fr, int fq) const {
        const int row0 = u.pm * BM + wr * 64 + fr; int colt = u.pn * BM; bf16_t* base = O;
        float sc = 1.f; if (split_cols) { const int t = colt / split_cols; base += (size_t)t * split_stride; colt -= t * split_cols; if (t == 0) sc = scale0; }
        const int col0 = colt + wc * 32 + 8 * fq, bcol0 = u.pn * BM + wc * 32 + 8 * fq;
        f32x4 bv[2][2];
#pragma unroll
        for (int bj = 0; bj < 2; ++bj)
#pragma unroll
            for (int n = 0; n < 2; ++n) bv[bj][n] = bias ? *(const f32x4*)(bias + bcol0 + bj * HALF + 4 * n) : (f32x4){0.f, 0.f, 0.f, 0.f};
#pragma unroll
        for (int ai = 0; ai < 2; ++ai)
#pragma unroll
            for (int m = 0; m < 4; ++m) { bf16_t* rowp = base + (size_t)(row0 + ai * HALF + m * 16) * ldc + col0;
#pragma unroll
                for (int bj = 0; bj < 2; ++bj) { f32x4 v0 = acc[ai][bj][m][0] + bv[bj][0], v1 = acc[ai][bj][m][1] + bv[bj][1];
                    if (ACT == 1) { f32x2 a = gelu_pk((f32x2){v0[0], v0[1]}), b = gelu_pk((f32x2){v0[2], v0[3]}), c = gelu_pk((f32x2){v1[0], v1[1]}), d = gelu_pk((f32x2){v1[2], v1[3]});
                        v0 = (f32x4){a.x, a.y, b.x, b.y}; v1 = (f32x4){c.x, c.y, d.x, d.y}; }
                    v0 = v0 * sc; v1 = v1 * sc; u32x4 w; w.x = cvt_pk_bf16(v0[0], v0[1]); w.y = cvt_pk_bf16(v0[2], v0[3]); w.z = cvt_pk_bf16(v1[0], v1[1]); w.w = cvt_pk_bf16(v1[2], v1[3]);
                    *(u32x4*)(rowp + bj * HALF) = w; } }
    }
};

struct EpiV1f {
    static constexpr bool PERM = false, AFTER_DRAIN = false;
    const float* x; const float* ada; float* V1;
    __device__ __forceinline__ void operator()(const f32x4 (&acc)[2][2][4][2], const Unit& u, int wr, int wc, int fr, int fq) const {
        const int row0 = u.pm * BM + wr * 64 + fr, col0 = u.pn * BM + wc * 32 + 4 * fq; const int b = (u.pm * BM) / 2048;
        f32x4 gv[2][2];
#pragma unroll
        for (int bj = 0; bj < 2; ++bj)
#pragma unroll
            for (int n = 0; n < 2; ++n) gv[bj][n] = *(const f32x4*)(ada + (size_t)b * 6144 + 2048 + col0 + bj * HALF + n * 16);
#pragma unroll
        for (int ai = 0; ai < 2; ++ai)
#pragma unroll
            for (int m = 0; m < 4; ++m) { const size_t off = (size_t)(row0 + ai * HALF + m * 16) * 1024 + col0;
#pragma unroll
                for (int bj = 0; bj < 2; ++bj)
#pragma unroll
                    for (int n = 0; n < 2; ++n) { const f32x4 xv = *(const f32x4*)(x + off + bj * HALF + n * 16);
                        *(f32x4*)(V1 + off + bj * HALF + n * 16) = xv * 1.189207115002721f + gv[bj][n] * acc[ai][bj][m][n]; } }
    }
};


template <int NSUB> struct MoeOrder {
    const int* tile_e; int nunits, G, c;
    __device__ void init(const int* te, int G_, int c_) { tile_e = te; nunits = te[160] * NSUB; G = G_; c = c_; }
    __device__ bool next(int i, Unit& u) const { const int L = i * G + c; if (L >= nunits) return false; u.pm = L / NSUB; u.pn = tile_e[u.pm] * NSUB + (L % NSUB); u.ka = 0; return true; }
    __device__ __forceinline__ void a_ready(const Unit&) const {}
    __device__ __forceinline__ void done(const Unit&) const {}
};
struct EpiMoeUp {
    static constexpr bool PERM = true, AFTER_DRAIN = false;
    bf16_t* Hs; const float* slot_w;
    __device__ __forceinline__ void operator()(const f32x4 (&acc)[2][2][4][2], const Unit& u, int wr, int wc, int fr, int fq) const {
        const int row0 = u.pm * BM + wr * 64 + fr, col0 = (u.pn & 1) * HALF + wc * 32 + 8 * fq;
#pragma unroll
        for (int ai = 0; ai < 2; ++ai)
#pragma unroll
            for (int m = 0; m < 4; ++m) { const int slot = row0 + ai * HALF + m * 16; const float w = slot_w[slot];
                float hv[8];
#pragma unroll
                for (int n = 0; n < 2; ++n)
#pragma unroll
                    for (int j = 0; j < 4; ++j) { const float a = acc[ai][0][m][n][j], b = acc[ai][1][m][n][j]; hv[4 * n + j] = a * __builtin_amdgcn_rcpf(1.0f + __builtin_amdgcn_exp2f(-1.4426950408889634f * a)) * b * w; }
                u32x4 o; o.x = cvt_pk_bf16(hv[0], hv[1]); o.y = cvt_pk_bf16(hv[2], hv[3]); o.z = cvt_pk_bf16(hv[4], hv[5]); o.w = cvt_pk_bf16(hv[6], hv[7]);
                *(u32x4*)(Hs + (size_t)slot * 256 + col0) = o; }
    }
};

template <class Epi, class Sched, bool ALIGN_EPI = false, bool SP2 = false>
__device__ __forceinline__ void gemm_phase(PG8_LAS unsigned char* lds, const Gemm g, const Sched& S, const Epi& E) {
    const int tid = tid_fresh(), wid = __builtin_amdgcn_readfirstlane(tid >> 6), lane = tid & 63, wr = wid >> 2, wc = wid & 3, fr = lane & 15, fq = lane >> 4;
    const int K = g.K, nt = K / BK;
    unsigned voffA[2], voffB[2];
#pragma unroll
    for (int i = 0; i < 2; ++i) { int R, C; stage_rc(tid * 16 + i * 8192, R, C); const int Rb = Epi::PERM ? ((R & ~31) + perm32(R & 31)) : R;
        voffA[i] = (unsigned)(R * g.lda + C) * 2u; voffB[i] = (unsigned)(Rb * g.ldb + C) * 2u; }
    const size_t kstep = (size_t)(BK * 2);
    const size_t hstepA = (size_t)HALF * g.lda * 2, hstepB = (size_t)HALF * g.ldb * 2;
    const size_t tstepA = 2 * hstepA, tstepB = 2 * hstepB;
    const unsigned ldsw = (unsigned)wid * 1024u;
    const int aoff = lds_byte(wr * 64 + fr, fq * 8), boff = lds_byte(wc * 32 + fr, fq * 8);
#define PG8_SA(b, h) (((b) * 2 + (h)) * HTB)
#define PG8_SB(b, h) ((4 + (b) * 2 + (h)) * HTB)
#define PG8_STAGE(bufoff, gbase, voff) do { _Pragma("unroll") for (int _i = 0; _i < 2; ++_i) \
        __builtin_amdgcn_global_load_lds((const unsigned*)((const char*)(gbase) + (voff)[_i]), (PG8_LAS unsigned*)(lds + (bufoff) + ldsw + _i * 8192), 16, 0, 0); } while (0)
#define PG8_LDA(dst, b, h) do { _Pragma("unroll") for (int m = 0; m < 4; ++m) _Pragma("unroll") for (int k = 0; k < 2; ++k) dst[m][k] = *(const PG8_LAS bf16x8*)(lds + PG8_SA(b, h) + aoff + m * 2048 + k * 1024); } while (0)
#define PG8_LDB(dst, b, h) do { _Pragma("unroll") for (int n = 0; n < 2; ++n) _Pragma("unroll") for (int k = 0; k < 2; ++k) dst[n][k] = *(const PG8_LAS bf16x8*)(lds + PG8_SB(b, h) + boff + n * 2048 + k * 1024); } while (0)
#define PG8_MMA(ai, bj, At, Bt) do { __builtin_amdgcn_s_setprio(1); _Pragma("unroll") for (int m = 0; m < 4; ++m) _Pragma("unroll") for (int n = 0; n < 2; ++n) _Pragma("unroll") for (int k = 0; k < 2; ++k) \
        acc[ai][bj][m][n] = __builtin_amdgcn_mfma_f32_16x16x32_bf16(Bt[n][k], At[m][k], acc[ai][bj][m][n], 0, 0, 0); __builtin_amdgcn_s_setprio(0); } while (0)
#define PG8_WAIT_V(n) asm volatile("s_waitcnt vmcnt(" #n ")" ::: "memory")
#define PG8_WAIT_L(n) asm volatile("s_waitcnt lgkmcnt(" #n ")" ::: "memory")
#define PG8_BAR __builtin_amdgcn_s_barrier()
#define PG8_SCHED __builtin_amdgcn_sched_barrier(0)
    Unit cur, nxt; int ui = 0;
    if (!S.next(0, cur)) return;
    f32x4 acc[2][2][4][2];
#pragma unroll
    for (int a = 0; a < 2; ++a)
#pragma unroll
        for (int b = 0; b < 2; ++b)
#pragma unroll
            for (int m = 0; m < 4; ++m)
#pragma unroll
                for (int n = 0; n < 2; ++n) acc[a][b][m][n] = (f32x4){0.f, 0.f, 0.f, 0.f};
    bf16x8 At[4][2], B0[2][2], B1[2][2];
    const char* cA = (const char*)g.A + (size_t)cur.pm * tstepA + (size_t)cur.ka * 2; const char* cB = (const char*)g.Bt + (size_t)cur.pn * tstepB + (size_t)cur.ka * 2;
    S.a_ready(cur);
    if constexpr (SP2) {
        PG8_STAGE(PG8_SB(0, 0), cB, voffB); PG8_STAGE(PG8_SB(0, 1), cB + hstepB, voffB); PG8_STAGE(PG8_SA(0, 0), cA, voffA); PG8_STAGE(PG8_SA(0, 1), cA + hstepA, voffA);
        if (wr == 1) PG8_BAR;
        PG8_WAIT_V(2); PG8_BAR;
        PG8_STAGE(PG8_SB(1, 0), cB + kstep, voffB); PG8_STAGE(PG8_SA(1, 0), cA + kstep, voffA); PG8_STAGE(PG8_SB(1, 1), cB + hstepB + kstep, voffB);
        PG8_WAIT_V(6); PG8_BAR;
    } else {
        PG8_STAGE(PG8_SB(0, 0), cB, voffB); PG8_STAGE(PG8_SA(0, 0), cA, voffA); PG8_STAGE(PG8_SB(0, 1), cB + hstepB, voffB); PG8_STAGE(PG8_SA(0, 1), cA + hstepA, voffA);
        if (wr == 1) PG8_BAR;
        PG8_WAIT_V(4); PG8_BAR;
        PG8_STAGE(PG8_SB(1, 0), cB + kstep, voffB); PG8_STAGE(PG8_SA(1, 0), cA + kstep, voffA); PG8_STAGE(PG8_SB(1, 1), cB + hstepB + kstep, voffB);
        PG8_WAIT_V(6); PG8_BAR;
    }
    for (;;) {
        const bool has_next = S.next(ui + 1, nxt);
        const char* nA = has_next ? (const char*)g.A + (size_t)nxt.pm * tstepA + (size_t)nxt.ka * 2 : cA; const char* nB = has_next ? (const char*)g.Bt + (size_t)nxt.pn * tstepB + (size_t)nxt.ka * 2 : cB;
        for (int t = 0; t < nt; t += 2) {
            const bool last = (t == nt - 2);
            const char* a1 = cA + (size_t)(t + 1) * kstep;
            const char* a2 = last ? nA : cA + (size_t)(t + 2) * kstep; const char* b2 = last ? nB : cB + (size_t)(t + 2) * kstep;
            const char* a3 = a2 + kstep; const char* b3 = b2 + kstep;
            if (last && has_next) S.a_ready(nxt);
            if constexpr (SP2) {
            PG8_LDB(B0, 0, 0); PG8_LDB(B1, 0, 1); PG8_SCHED; PG8_LDA(At, 0, 0); PG8_STAGE(PG8_SA(1, 1), a1 + hstepA, voffA);
            PG8_WAIT_V(8); PG8_WAIT_L(0); PG8_BAR; PG8_MMA(0, 0, At, B0); PG8_MMA(0, 1, At, B1); PG8_BAR; PG8_SCHED;
            PG8_LDA(At, 0, 1); PG8_STAGE(PG8_SB(0, 0), b2, voffB); PG8_STAGE(PG8_SB(0, 1), b2 + hstepB, voffB); PG8_STAGE(PG8_SA(0, 0), a2, voffA);
            PG8_WAIT_V(8); PG8_WAIT_L(0); PG8_BAR; PG8_MMA(1, 0, At, B0); PG8_MMA(1, 1, At, B1); PG8_BAR; PG8_SCHED;
            PG8_LDB(B0, 1, 0); PG8_LDB(B1, 1, 1); PG8_SCHED; PG8_LDA(At, 1, 0); PG8_STAGE(PG8_SA(0, 1), a2 + hstepA, voffA);
            PG8_WAIT_V(8); PG8_WAIT_L(0); PG8_BAR; PG8_MMA(0, 0, At, B0); PG8_MMA(0, 1, At, B1); PG8_BAR; PG8_SCHED;
            PG8_LDA(At, 1, 1); PG8_STAGE(PG8_SB(1, 0), b3, voffB); PG8_STAGE(PG8_SB(1, 1), b3 + hstepB, voffB); PG8_STAGE(PG8_SA(1, 0), a3, voffA);
            PG8_WAIT_V(8); PG8_WAIT_L(0); PG8_BAR; PG8_MMA(1, 0, At, B0); PG8_MMA(1, 1, At, B1); PG8_BAR; PG8_SCHED;
            } else {
            PG8_LDB(B0, 0, 0); PG8_SCHED; PG8_LDA(At, 0, 0); PG8_STAGE(PG8_SA(1, 1), a1 + hstepA, voffA);
            PG8_WAIT_L(8); PG8_BAR; PG8_WAIT_L(0); PG8_MMA(0, 0, At, B0); PG8_BAR; PG8_SCHED;
            PG8_LDB(B1, 0, 1); PG8_STAGE(PG8_SB(0, 0), b2, voffB);
            PG8_BAR; PG8_WAIT_L(0); PG8_MMA(0, 1, At, B1); PG8_BAR;
            PG8_LDA(At, 0, 1); PG8_STAGE(PG8_SA(0, 0), a2, voffA);
            PG8_BAR; PG8_WAIT_L(0); PG8_MMA(1, 0, At, B0); PG8_BAR; PG8_SCHED;
            PG8_STAGE(PG8_SB(0, 1), b2 + hstepB, voffB);
            PG8_WAIT_V(6); PG8_BAR; PG8_MMA(1, 1, At, B1); PG8_BAR;
            PG8_LDB(B0, 1, 0); PG8_SCHED; PG8_LDA(At, 1, 0); PG8_STAGE(PG8_SA(0, 1), a2 + hstepA, voffA);
            PG8_WAIT_L(8); PG8_BAR; PG8_WAIT_L(0); PG8_MMA(0, 0, At, B0); PG8_BAR; PG8_SCHED;
            PG8_LDB(B1, 1, 1); PG8_STAGE(PG8_SB(1, 0), b3, voffB);
            PG8_BAR; PG8_WAIT_L(0); PG8_MMA(0, 1, At, B1); PG8_BAR;
            PG8_LDA(At, 1, 1); PG8_STAGE(PG8_SA(1, 0), a3, voffA);
            PG8_BAR; PG8_WAIT_L(0); PG8_MMA(1, 0, At, B0); PG8_BAR; PG8_SCHED;
            PG8_STAGE(PG8_SB(1, 1), b3 + hstepB, voffB);
            PG8_WAIT_V(6); PG8_BAR; PG8_MMA(1, 1, At, B1); PG8_BAR;
            }
        }
        if constexpr (ALIGN_EPI) { if (wr == 0) PG8_BAR; }
        if constexpr (!Epi::AFTER_DRAIN) { E(acc, cur, wr, wc, fr, fq); S.done(cur); }
        if (!has_next) break;
#pragma unroll
        for (int a = 0; a < 2; ++a)
#pragma unroll
            for (int b = 0; b < 2; ++b)
#pragma unroll
                for (int m = 0; m < 4; ++m)
#pragma unroll
                    for (int n = 0; n < 2; ++n) acc[a][b][m][n] = (f32x4){0.f, 0.f, 0.f, 0.f};
        cur = nxt; cA = nA; cB = nB; ++ui;
        if constexpr (ALIGN_EPI) { if (wr == 1) PG8_BAR; }
    }
    PG8_WAIT_V(0);
    if constexpr (!ALIGN_EPI) { if (wr == 0) PG8_BAR; }
    PG8_BAR;
    if constexpr (Epi::AFTER_DRAIN) { E.fused(acc, cur, wr, wc, fr, fq, lds, wid, lane); S.done(cur); }
#undef PG8_SA
#undef PG8_SB
#undef PG8_STAGE
#undef PG8_LDA
#undef PG8_LDB
#undef PG8_MMA
#undef PG8_WAIT_V
#undef PG8_WAIT_L
#undef PG8_BAR
#undef PG8_SCHED
}
}

__device__ __forceinline__ void p0_transpose_item(const float* W, int K, int N, bf16* WT, int row_off, float* scr, int item, int lane) {
    const int nblk = N / 32, kb = item / nblk, nb = item % nblk, k0 = 64 * kb, n0 = 32 * nb;
#pragma unroll 8
    for (int i = 0; i < 32; ++i) { const int kk = 2 * i + (lane >> 5); scr[kk * 33 + (lane & 31)] = W[(size_t)(k0 + kk) * N + n0 + (lane & 31)]; }
    asm volatile("s_waitcnt lgkmcnt(0)" ::: "memory");
    const int c = lane & 7;
#pragma unroll
    for (int j = 0; j < 4; ++j) { const int n = (lane >> 3) + 8 * j; const float* s = scr + (8 * c) * 33 + n;
        uint4 o; o.x = pk2(s[0 * 33], s[1 * 33]); o.y = pk2(s[2 * 33], s[3 * 33]); o.z = pk2(s[4 * 33], s[5 * 33]); o.w = pk2(s[6 * 33], s[7 * 33]);
        *(uint4*)(WT + (size_t)(row_off + n0 + n) * K + k0 + 8 * c) = o; }
    asm volatile("s_waitcnt lgkmcnt(0)" ::: "memory");
}
__device__ __forceinline__ void ph_convert(float* lds, const Args& a, bf16* Win_t, bf16* Wout_t, bf16* W13_t, bf16* W2_t, bf16* Wpool_t, bf16* Wr_t) {
    const int tid = tid_fresh(), lane = tid & 63, wave = tid >> 6;
    float* scr = lds + wave * (64 * 33);
    const int gw = blockIdx.x * 8 + wave, NGW = gridDim.x * 8;
    constexpr int I_IN = 16 * 80, I_OUT = 16 * 32, I_E13 = 16 * 8, I_E2 = 4 * 32, I_PL = 2 * 4;
    constexpr int NITEMS = I_IN + I_OUT + NE * 2 * I_E13 + NE * I_E2 + 4 * I_PL;
    for (int it = gw; it < NITEMS; it += NGW) {
        int r = it;
        if (r < I_IN) { p0_transpose_item((const float*)a.in[I_WIN], D, INC, Win_t, 0, scr, r, lane); continue; } r -= I_IN;
        if (r < I_OUT) { p0_transpose_item((const float*)a.in[I_WOUT], D, D, Wout_t, 0, scr, r, lane); continue; } r -= I_OUT;
        if (r < NE * 2 * I_E13) { const int e = r / (2 * I_E13), q = r % (2 * I_E13), is3 = q / I_E13, item = q % I_E13; const int h = (item % 8) / 4;
            const float* W = (const float*)a.in[is3 ? I_W3 : I_W1] + (size_t)e * D * DE;
            p0_transpose_item(W, D, DE, W13_t, e * 512 + h * 128 + is3 * 128, scr, item, lane); continue; } r -= NE * 2 * I_E13;
        if (r < NE * I_E2) { const int e = r / I_E2, item = r % I_E2; p0_transpose_item((const float*)a.in[I_W2] + (size_t)e * DE * D, DE, D, W2_t, e * 1024, scr, item, lane); continue; } r -= NE * I_E2;
        { const int g = r / I_PL, item = r % I_PL; p0_transpose_item((const float*)a.in[I_WPOOL] + (size_t)g * 128 * 128, 128, 128, Wpool_t, g * 128, scr, item, lane); }
    }
    { const float* wg = (const float*)a.in[I_WGRP]; const float* wr = (const float*)a.in[I_WRT];
      for (int it = blockIdx.x * NTHR + tid; it < 256 * 128; it += gridDim.x * NTHR) { const int j = it >> 7, k0 = (it & 127) * 8; float v[8];
#pragma unroll
          for (int q = 0; q < 8; ++q) v[q] = (j < 4) ? wg[(size_t)(k0 + q) * 4 + j] : (j < 36 ? wr[(size_t)(k0 + q) * 32 + (j - 4)] : 0.f);
          *(uint4*)(Wr_t + (size_t)j * D + k0) = make_uint4(pk2(v[0], v[1]), pk2(v[2], v[3]), pk2(v[4], v[5]), pk2(v[6], v[7])); } }
}

#define LAS __attribute__((address_space(3)))
#define XB_TMO      128
#define XB_XCNT(j)  (256  + 64 * (j))
#define XB_XSUB(j)  (1280 + 64 * (j))
#define XB_XGEN(j)  (2304 + 64 * (j))
#define XB_TOP      3328
#define XB_TOPGEN   3392
#define XCD_BAR_WORDS 3456
#define XB_SPIN_CAP (1u << 22)
__device__ __forceinline__ unsigned xb_ld(unsigned* p)              { return __hip_atomic_load(p, __ATOMIC_RELAXED, __HIP_MEMORY_SCOPE_AGENT); }
__device__ __forceinline__ unsigned xb_add(unsigned* p, unsigned v) { return __hip_atomic_fetch_add(p, v, __ATOMIC_RELAXED, __HIP_MEMORY_SCOPE_AGENT); }
__device__ __forceinline__ unsigned xb_xcc_id() { return (unsigned)__builtin_amdgcn_s_getreg((3 << 11) | 20) & 0xFu; }
#define XB_SPIN(cond, bar) do { unsigned _sp = 0; while (cond) { __builtin_amdgcn_s_sleep(1); \
    if ((++_sp & 255u) == 0u) { if (xb_ld(&(bar)[XB_TMO])) break; if (_sp > XB_SPIN_CAP) { atomicAdd(&(bar)[XB_TMO], 1u); break; } } } } while (0)
struct XcdBarrier { unsigned* bar; unsigned x; volatile LAS unsigned* st; };
__device__ __forceinline__ XcdBarrier xcd_barrier_post(unsigned* bar, volatile LAS unsigned* st) {
    XcdBarrier b; b.bar = bar; b.x = xb_xcc_id(); b.st = st;
    if (threadIdx.x == 0) (void)xb_add(&bar[XB_XCNT(b.x)], 1u);
    return b;
}
__device__ __forceinline__ void xcd_barrier_complete(unsigned* bar, unsigned x, unsigned& nloc, unsigned& nx) {
    const unsigned G = gridDim.x * gridDim.y * gridDim.z;
    unsigned sum, cnt, mine, sp = 0u;
    for (;;) {
        sum = 0u; cnt = 0u; mine = 0u;
#pragma unroll
        for (unsigned j = 0; j < 16; ++j) { const unsigned c = xb_ld(&bar[XB_XCNT(j)]); sum += c; cnt += (c > 0u) ? 1u : 0u; mine = (j == x) ? c : mine; }
        if (sum == G) break;
        __builtin_amdgcn_s_sleep(1);
        if ((++sp & 255u) == 0u) { if (xb_ld(&bar[XB_TMO])) break; if (sp > XB_SPIN_CAP) { atomicAdd(&bar[XB_TMO], 1u); break; } }
    }
    nloc = mine > 0u ? mine : 1u; nx = cnt > 0u ? cnt : 1u;
}
__device__ __forceinline__ void xcd_barrier(const XcdBarrier& b) {
    asm volatile("s_waitcnt vmcnt(0)" ::: "memory");
    __syncthreads();
    if (threadIdx.x == 0) {
        unsigned* bar = b.bar;
        __builtin_amdgcn_s_waitcnt(0);
        unsigned nloc = b.st[0], nx = b.st[1];
        if (nloc == 0u) { xcd_barrier_complete(bar, b.x, nloc, nx); b.st[0] = nloc; b.st[1] = nx; }
        const unsigned old = xb_add(&bar[XB_XSUB(b.x)], 1u);
        const unsigned gen = old / nloc;
        if (old + 1u == (gen + 1u) * nloc) {
            __builtin_amdgcn_fence(__ATOMIC_RELEASE, "agent");
            asm volatile("s_waitcnt vmcnt(0)" ::: "memory");
            const unsigned og = xb_add(&bar[XB_TOP], 1u);
            const unsigned tg = og / nx;
            if (og + 1u == (tg + 1u) * nx) xb_add(&bar[XB_TOPGEN], 1u);
            else XB_SPIN(xb_ld(&bar[XB_TOPGEN]) == tg, bar);
            __builtin_amdgcn_fence(__ATOMIC_ACQUIRE, "agent");
            xb_add(&bar[XB_XGEN(b.x)], 1u);
            asm volatile("s_waitcnt vmcnt(0)" ::: "memory");
        } else {
            XB_SPIN(xb_ld(&bar[XB_XGEN(b.x)]) == gen, bar);
            __builtin_amdgcn_fence(__ATOMIC_ACQUIRE, "agent");
            asm volatile("s_waitcnt vmcnt(0)" ::: "memory");
        }
    }
    __syncthreads();
}
constexpr int CW_BAR = 1024;


namespace rt {
typedef short bf16x8 __attribute__((ext_vector_type(8)));
typedef short s16x4 __attribute__((ext_vector_type(4)));
typedef float f32x16 __attribute__((ext_vector_type(16)));
typedef __bf16 bf16x2v __attribute__((ext_vector_type(2)));
typedef float f32x2v __attribute__((ext_vector_type(2)));
typedef unsigned u32x4 __attribute__((ext_vector_type(4)));
__device__ __forceinline__ void lds_st16(LAS unsigned char* p, unsigned x, unsigned y, unsigned z, unsigned w) { u32x4 v = {x, y, z, w}; *(LAS u32x4*)p = v; }
__device__ __forceinline__ u32x4 lds_ld16(const LAS unsigned char* p) { return *(const LAS u32x4*)p; }
#define RT_MFMA(a, b, c) __builtin_amdgcn_mfma_f32_32x32x16_bf16((a), (b), (c), 0, 0, 0)
__device__ __forceinline__ unsigned off_b(unsigned row, unsigned ch) { return 256u * row + 16u * (ch ^ (((row & 3u) << 2) | ((row >> 2) & 3u))); }
__device__ __forceinline__ unsigned cvt2(float lo, float hi) { f32x2v f = {lo, hi}; return __builtin_bit_cast(unsigned, __builtin_convertvector(f, bf16x2v)); }
__device__ __forceinline__ int crow(int reg, int h) { return (reg & 3) + 8 * (reg >> 2) + 4 * h; }
__device__ __forceinline__ bf16x8 row_frag(const LAS unsigned char* img, int rb, int s, int lane) { return *(const LAS bf16x8*)(img + off_b(32 * rb + (lane & 31), 2 * s + (lane >> 5))); }
__device__ __forceinline__ bf16x8 tr_frag(const LAS unsigned char* img, int cb, int r0, int r1, int lane) {
    const int blk = (lane >> 4) & 1, q = (lane & 15) >> 2, p = lane & 3; const unsigned ch = 4 * cb + 2 * blk + (p >> 1), sub = 8 * (p & 1);
    const s16x4 lo = __builtin_amdgcn_ds_read_tr16_b64_v4i16((LAS s16x4*)(img + off_b(r0 + q, ch) + sub));
    const s16x4 hi = __builtin_amdgcn_ds_read_tr16_b64_v4i16((LAS s16x4*)(img + off_b(r1 + q, ch) + sub));
    return __builtin_shufflevector(lo, hi, 0, 1, 2, 3, 4, 5, 6, 7);
}
__device__ __forceinline__ bf16x8 tr_frag_nat(const LAS unsigned char* img, int cb, int ks, int lane) { const int h = lane >> 5; return tr_frag(img, cb, 16 * ks + 8 * h, 16 * ks + 8 * h + 4, lane); }
__device__ __forceinline__ bf16x8 tr_frag_acc(const LAS unsigned char* img, int cb, int kb, int lane) { const int h = lane >> 5; return tr_frag(img, cb, kb + 4 * h, kb + 8 + 4 * h, lane); }
template <int S> __device__ __forceinline__ bf16x8 pack_acc(const f32x16& x) { u32x4 p; p.x = cvt2(x[8 * S], x[8 * S + 1]); p.y = cvt2(x[8 * S + 2], x[8 * S + 3]); p.z = cvt2(x[8 * S + 4], x[8 * S + 5]); p.w = cvt2(x[8 * S + 6], x[8 * S + 7]); return __builtin_bit_cast(bf16x8, p); }

__device__ __forceinline__ void stage_rot_tile(LAS unsigned char* img, const bf16* src  , const float2* rot  , float scale, bool kdec, float log2g, int tid) {
#pragma unroll
    for (int i = 0; i < 2; ++i) { const int it = tid + NTHR * i, r = it >> 3, c8 = it & 7;
        const uint4 lo = *(const uint4*)(src + (size_t)r * INC + 8 * c8), hi = *(const uint4*)(src + (size_t)r * INC + 64 + 8 * c8);
        const float4* cs = (const float4*)(rot + (size_t)r * 64 + 8 * c8);
        const float f = kdec ? scale * exp2f((float)(127 - r) * log2g) : scale;
        const unsigned lw[4] = {lo.x, lo.y, lo.z, lo.w}, hw[4] = {hi.x, hi.y, hi.z, hi.w}; unsigned o1[4], o2[4];
#pragma unroll
        for (int w = 0; w < 4; ++w) { const float4 c = cs[w];
            const float a0 = bflo(lw[w]), a1 = bfhi(lw[w]), b0 = bflo(hw[w]), b1 = bfhi(hw[w]);
            o1[w] = cvt2((a0 * c.x - b0 * c.y) * f, (a1 * c.z - b1 * c.w) * f); o2[w] = cvt2((a0 * c.y + b0 * c.x) * f, (a1 * c.w + b1 * c.z) * f); }
        lds_st16(img + off_b(r, c8), o1[0], o1[1], o1[2], o1[3]); lds_st16(img + off_b(r, c8 + 8), o2[0], o2[1], o2[2], o2[3]); }
}
__device__ __forceinline__ void stage_copy_tile(LAS unsigned char* img, const bf16* src, int ld, int tid) {
#pragma unroll
    for (int i = 0; i < 4; ++i) { const int it = tid + NTHR * i, r = it >> 4, ch = it & 15; const uint4 v = *(const uint4*)(src + (size_t)r * ld + 8 * ch); lds_st16(img + off_b(r, ch), v.x, v.y, v.z, v.w); }
}
__device__ __forceinline__ void stage_f32_tile(LAS unsigned char* img, const float* src, int tid) {
#pragma unroll
    for (int i = 0; i < 4; ++i) { const int it = tid + NTHR * i, r = it >> 4, ch = it & 15; const float4 a = *(const float4*)(src + r * 128 + 8 * ch), b = *(const float4*)(src + r * 128 + 8 * ch + 4);
        lds_st16(img + off_b(r, ch), cvt2(a.x, a.y), cvt2(a.z, a.w), cvt2(b.x, b.y), cvt2(b.z, b.w)); }
}

__device__ __forceinline__ void ph_kv(LAS unsigned char* lds, const bf16* proj, const float2* rot, float* KV) {
    const int tid = tid_fresh(), lane = tid & 63, wave = tid >> 6, eb = wave >> 1, dh = wave & 1, hl = lane >> 5;
    LAS unsigned char* Kimg = lds; LAS unsigned char* Vimg = lds + 32768;
    for (int unit = blockIdx.x; unit < 512; unit += gridDim.x) {
        const int h = unit & 3, bn = unit >> 2; const size_t row0 = (size_t)bn * 128;
        const float log2g = log2f(1.0f - exp2f(-5.0f - (float)h));
        __syncthreads();
        stage_rot_tile(Kimg, proj + row0 * INC + 512 + h * 128, rot + row0 * 64, 0.08838834764831845f, true, log2g, tid);
        stage_copy_tile(Vimg, proj + row0 * INC + 1024 + h * 128, INC, tid);
        __syncthreads();
        f32x16 acc[2];
#pragma unroll
        for (int j = 0; j < 2; ++j)
#pragma unroll
            for (int q = 0; q < 16; ++q) acc[j][q] = 0.f;
#pragma unroll
        for (int ks = 0; ks < 8; ++ks) { const bf16x8 a = tr_frag_nat(Vimg, eb, ks, lane);
#pragma unroll
            for (int j = 0; j < 2; ++j) { const bf16x8 bq = tr_frag_nat(Kimg, 2 * dh + j, ks, lane); acc[j] = RT_MFMA(a, bq, acc[j]); } }
        float* out = KV + (size_t)unit * 16384;
#pragma unroll
        for (int j = 0; j < 2; ++j)
#pragma unroll
            for (int q = 0; q < 16; ++q) out[(32 * eb + crow(q, hl)) * 128 + 32 * (2 * dh + j) + (lane & 31)] = acc[j][q];
    }
}
__device__ __forceinline__ void ph_scan(float* KV) {
    for (int it = blockIdx.x * NTHR + tid_fresh(); it < 32 * 4096; it += gridDim.x * NTHR) {
        const int bh = it >> 12, idx = it & 4095, b = bh >> 2, h = bh & 3;
        const float cd = exp2f(128.0f * log2f(1.0f - exp2f(-5.0f - (float)h)));
        float4* p = (float4*)KV + ((size_t)(b * 16) * 4 + h) * 4096 + idx;
        float4 v[16];
#pragma unroll
        for (int n = 0; n < 16; ++n) v[n] = p[(size_t)n * 4 * 4096];
        float4 st = make_float4(0.f, 0.f, 0.f, 0.f);
#pragma unroll
        for (int n = 0; n < 16; ++n) { p[(size_t)n * 4 * 4096] = st; st.x = st.x * cd + v[n].x; st.y = st.y * cd + v[n].y; st.z = st.z * cd + v[n].z; st.w = st.w * cd + v[n].w; }
    }
}
__device__ __forceinline__ void ph_retention(LAS unsigned char* lds, const bf16* proj, const float2* rot, const float* KV, const float* gnw, bf16* mix) {
    const int tid = tid_fresh(), lane = tid & 63, wave = tid >> 6, ib = wave >> 1, eh = wave & 1, hl = lane >> 5, il = lane & 31;
    LAS unsigned char* Qimg = lds; LAS unsigned char* Kimg = lds + 32768; LAS unsigned char* Vimg = lds + 65536; LAS unsigned char* Simg = lds + 98304;
    LAS float* red = (LAS float*)(lds + 131072);
    for (int unit = blockIdx.x; unit < 512; unit += gridDim.x) {
        const int h = unit & 3, bn = unit >> 2, n = bn & 15; const size_t row0 = (size_t)bn * 128;
        const float log2g = log2f(1.0f - exp2f(-5.0f - (float)h));
        __syncthreads();
        stage_rot_tile(Qimg, proj + row0 * INC + h * 128, rot + row0 * 64, 1.0f, false, 0.f, tid);
        stage_rot_tile(Kimg, proj + row0 * INC + 512 + h * 128, rot + row0 * 64, 1.0f, false, 0.f, tid);
        stage_copy_tile(Vimg, proj + row0 * INC + 1024 + h * 128, INC, tid);
        if (n > 0) stage_f32_tile(Simg, KV + (size_t)unit * 16384, tid);
        __syncthreads();
        bf16x8 qf[8];
#pragma unroll
        for (int s = 0; s < 8; ++s) qf[s] = row_frag(Qimg, ib, s, lane);
        f32x16 acc[2];
#pragma unroll
        for (int j = 0; j < 2; ++j)
#pragma unroll
            for (int q = 0; q < 16; ++q) acc[j][q] = 0.f;
        if (n > 0) {
#pragma unroll
            for (int s = 0; s < 8; ++s)
#pragma unroll
                for (int j = 0; j < 2; ++j) acc[j] = RT_MFMA(row_frag(Simg, 2 * eh + j, s, lane), qf[s], acc[j]);
            const float qd = exp2f((float)(32 * ib + il + 1) * log2g);
#pragma unroll
            for (int j = 0; j < 2; ++j)
#pragma unroll
                for (int q = 0; q < 16; ++q) acc[j][q] *= qd;
        }
        for (int mb = 0; mb <= ib; ++mb) {
            f32x16 sc;
#pragma unroll
            for (int q = 0; q < 16; ++q) sc[q] = 0.f;
#pragma unroll
            for (int s = 0; s < 8; ++s) sc = RT_MFMA(row_frag(Kimg, mb, s, lane), qf[s], sc);
            const int i = 32 * ib + il;
#pragma unroll
            for (int q = 0; q < 16; ++q) { const int m = 32 * mb + crow(q, hl); const float f = (i >= m) ? 0.08838834764831845f * exp2f((float)(i - m) * log2g) : 0.f; sc[q] *= f; }
            const bf16x8 p0 = pack_acc<0>(sc), p1 = pack_acc<1>(sc);
#pragma unroll
            for (int j = 0; j < 2; ++j) { acc[j] = RT_MFMA(tr_frag_acc(Vimg, 2 * eh + j, 32 * mb, lane), p0, acc[j]); acc[j] = RT_MFMA(tr_frag_acc(Vimg, 2 * eh + j, 32 * mb + 16, lane), p1, acc[j]); }
        }
        float s1 = 0.f, s2 = 0.f;
#pragma unroll
        for (int j = 0; j < 2; ++j)
#pragma unroll
            for (int q = 0; q < 16; ++q) { s1 += acc[j][q]; s2 += acc[j][q] * acc[j][q]; }
        s1 += __shfl_xor(s1, 32); s2 += __shfl_xor(s2, 32);
        if (hl == 0) { red[(wave * 32 + il) * 2] = s1; red[(wave * 32 + il) * 2 + 1] = s2; }
        __syncthreads();
        { const int ow = wave ^ 1; s1 += red[(ow * 32 + il) * 2]; s2 += red[(ow * 32 + il) * 2 + 1]; }
        const float mean = s1 * (1.f / 128.f), var = fmaxf(s2 * (1.f / 128.f) - mean * mean, 0.f), rstd = 1.f / sqrtf(var + LN_EPS);
        const size_t row = row0 + 32 * ib + il;
#pragma unroll
        for (int j = 0; j < 2; ++j)
#pragma unroll
            for (int g = 0; g < 4; ++g) { const int e0 = 32 * (2 * eh + j) + 8 * g + 4 * hl;
                const uint2 gr = *(const uint2*)(proj + row * INC + 1536 + h * 128 + e0); const float4 gw = *(const float4*)(gnw + h * 128 + e0);
                const float g0 = bflo(gr.x), g1 = bfhi(gr.x), g2 = bflo(gr.y), g3 = bfhi(gr.y);
                const float o0 = silu_f(g0) * ((acc[j][4 * g] - mean) * rstd * gw.x), o1 = silu_f(g1) * ((acc[j][4 * g + 1] - mean) * rstd * gw.y);
                const float o2 = silu_f(g2) * ((acc[j][4 * g + 2] - mean) * rstd * gw.z), o3 = silu_f(g3) * ((acc[j][4 * g + 3] - mean) * rstd * gw.w);
                *(uint2*)(mix + row * D + h * 128 + e0) = make_uint2(cvt2(o0, o1), cvt2(o2, o3)); }
    }
}
__device__ __forceinline__ void ph_pool(LAS unsigned char* lds, const bf16* proj, const bf16* Wpool_t, const float* pscale, bf16* mix) {
    const int tid = tid_fresh(), lane = tid & 63, wave = tid >> 6, tb = wave >> 1, dh = wave & 1, hl = lane >> 5, il = lane & 31;
    LAS unsigned char* Pin = lds;
    LAS unsigned char* Pimg = lds + 36864; LAS unsigned char* Wimg = lds + 36864 + 32768;
    for (int unit = blockIdx.x; unit < 512; unit += gridDim.x) {
        const int g = unit & 3, rb = unit >> 2, win = 2 << g; const int row0 = rb * 128, s0 = row0 & (SEQ - 1);
        __syncthreads();
        for (int it = tid; it < 143 * 16; it += NTHR) { const int pr = it >> 4, ch = it & 15; const int s = s0 + pr - 15;
            uint4 v = make_uint4(0u, 0u, 0u, 0u); if (s >= 0) v = *(const uint4*)(proj + (size_t)(row0 + pr - 15) * INC + 2048 + g * 128 + 8 * ch);
            lds_st16(Pin + pr * 256 + ch * 16, v.x, v.y, v.z, v.w); }
        stage_copy_tile(Wimg, Wpool_t + (size_t)g * 128 * 128, 128, tid);
        __syncthreads();
#pragma unroll
        for (int i = 0; i < 4; ++i) { const int it = tid + NTHR * i, r = it >> 4, ch = it & 15; const int s = s0 + r; const int cnt = (s + 1 < win) ? (s + 1) : win;
            float sum[8] = {0.f, 0.f, 0.f, 0.f, 0.f, 0.f, 0.f, 0.f};
            for (int j = 0; j < cnt; ++j) { const u32x4 v = lds_ld16(Pin + (r + 15 - j) * 256 + ch * 16);
                sum[0] += bflo(v.x); sum[1] += bfhi(v.x); sum[2] += bflo(v.y); sum[3] += bfhi(v.y); sum[4] += bflo(v.z); sum[5] += bfhi(v.z); sum[6] += bflo(v.w); sum[7] += bfhi(v.w); }
            const u32x4 me = lds_ld16(Pin + (r + 15) * 256 + ch * 16); const float ic = 1.0f / (float)cnt;
            lds_st16(Pimg + off_b(r, ch), cvt2(sum[0] * ic - bflo(me.x), sum[1] * ic - bfhi(me.x)), cvt2(sum[2] * ic - bflo(me.y), sum[3] * ic - bfhi(me.y)),
                                                            cvt2(sum[4] * ic - bflo(me.z), sum[5] * ic - bfhi(me.z)), cvt2(sum[6] * ic - bflo(me.w), sum[7] * ic - bfhi(me.w))); }
        __syncthreads();
        f32x16 acc[2];
#pragma unroll
        for (int j = 0; j < 2; ++j)
#pragma unroll
            for (int q = 0; q < 16; ++q) acc[j][q] = 0.f;
#pragma unroll
        for (int s = 0; s < 8; ++s) { const bf16x8 bq = row_frag(Pimg, tb, s, lane);
#pragma unroll
            for (int j = 0; j < 2; ++j) acc[j] = RT_MFMA(row_frag(Wimg, 2 * dh + j, s, lane), bq, acc[j]); }
        const size_t row = (size_t)row0 + 32 * tb + il;
#pragma unroll
        for (int j = 0; j < 2; ++j)
#pragma unroll
            for (int q = 0; q < 4; ++q) { const int d0 = 32 * (2 * dh + j) + 8 * q + 4 * hl; const float4 ps = *(const float4*)(pscale + g * 128 + d0);
                *(uint2*)(mix + row * D + 512 + g * 128 + d0) = make_uint2(cvt2(acc[j][4 * q] * ps.x, acc[j][4 * q + 1] * ps.y), cvt2(acc[j][4 * q + 2] * ps.z, acc[j][4 * q + 3] * ps.w)); }
    }
}
#undef RT_MFMA
}

constexpr int LDS_BYTES = 147456;
constexpr int MISC_OFF = LDS_BYTES - 64;
constexpr int N_PHASES = 13;

__global__ void __launch_bounds__(NTHR, 2) mk_fwd(Args args) {
    extern __shared__ __attribute__((aligned(16))) unsigned char lds_raw[];
    float* lds = (float*)lds_raw;
    unsigned char* ws = args.ws;
    const float* x = (const float*)args.in[I_X];
    float* part = (float*)(ws + WS_ADAP); float* ada = (float*)(ws + WS_ADA);
    int* tok_e = (int*)(ws + WS_TOKE); float* tok_w = (float*)(ws + WS_TOKW);
    float2* rot = (float2*)(ws + WS_ROT);
    bf16* U = (bf16*)(ws + WS_U); bf16* PROJ = (bf16*)(ws + WS_PROJ); float* V1 = (float*)(ws + WS_V1);
    float* LOG = (float*)(ws + WS_LOG); bf16* MIX = (bf16*)(ws + WS_MIX); float* Y2 = (float*)(ws + WS_Y2);
    volatile LAS unsigned* MISC = (volatile LAS unsigned*)((LAS unsigned char*)lds_raw + MISC_OFF);
    if (threadIdx.x < 16) MISC[threadIdx.x] = 0u;
    __syncthreads();
    XcdBarrier bar = xcd_barrier_post((unsigned*)(ws + WS_CTL) + CW_BAR, MISC);
    LAS unsigned char* ldsl = (LAS unsigned char*)lds_raw;
    float* KV = (float*)(ws + WS_KV);
#define GRID_BAR() xcd_barrier(bar)
    ph_ada_partial(lds, (const float*)args.in[I_C], (const float*)args.in[I_WADA], part); __syncthreads(); ph_rot_table((const int*)args.in[I_POS], rot);
    ph_convert(lds, args, (bf16*)(ws + WS_WIN), (bf16*)(ws + WS_WOUT), (bf16*)(ws + WS_W13), (bf16*)(ws + WS_W2), (bf16*)(ws + WS_WPOOL), (bf16*)(ws + WS_WR));
    GRID_BAR();
    ph_ada_final_lnmod(lds, x, part, (const float*)args.in[I_BADA], ada, U);
    GRID_BAR();
    { pg8::Gemm g{U, (const bf16*)(ws + WS_WIN), T, INC, D, D, D}; pg8::StaticOrder S; S.init(T, INC, (int)gridDim.x, (int)blockIdx.x);
      pg8::EpiBf16<0> E{PROJ, INC, nullptr, 0, 0, 1.f};
      pg8::gemm_phase<pg8::EpiBf16<0>, pg8::StaticOrder, true, true>(ldsl, g, S, E); }
    GRID_BAR();
#if USE_NAIVE_RET
    ph_ret_naive(lds, PROJ, rot, (const float*)args.in[I_GNW], MIX);
#else
    rt::ph_kv(ldsl, PROJ, rot, KV);
    GRID_BAR();
    rt::ph_scan(KV);
#endif
#if USE_NAIVE_POOL
    ph_pool_naive(lds, PROJ, (const float*)args.in[I_WPOOL], (const float*)args.in[I_PSCALE], MIX);
#else
    __syncthreads();
    rt::ph_pool(ldsl, PROJ, (const bf16*)(ws + WS_WPOOL), (const float*)args.in[I_PSCALE], MIX);
#endif
#if !USE_NAIVE_RET
    GRID_BAR();
    rt::ph_retention(ldsl, PROJ, rot, KV, (const float*)args.in[I_GNW], MIX);
#endif
    GRID_BAR();
    { pg8::Gemm g{MIX, (const bf16*)(ws + WS_WOUT), T, D, D, D, D}; pg8::StaticOrder S; S.init(T, D, (int)gridDim.x, (int)blockIdx.x);
      pg8::EpiV1f E{x, ada, V1};
      pg8::gemm_phase<pg8::EpiV1f, pg8::StaticOrder, true, true>(ldsl, g, S, E); }
    GRID_BAR();
    ph_ln1_ln2mod(V1, (const float*)args.in[I_LN1W], (const float*)args.in[I_LN1B], ada, U);
    GRID_BAR();
    ph_router_naive(lds, U, (const float*)args.in[I_WGRP], (const float*)args.in[I_WRT], LOG);
    GRID_BAR();
    ph_route_hist(lds, LOG, 1, (const float*)args.in[I_BGRP], (const float*)args.in[I_BRT], tok_e, tok_w, (int*)(ws + WS_HIST));
    GRID_BAR();
    ph_permute(lds, (const int*)(ws + WS_HIST), tok_e, tok_w, U, (int*)(ws + WS_TOKS), (float*)(ws + WS_SLOTW), (int*)(ws + WS_TILEE), (bf16*)(ws + WS_U2S));
    GRID_BAR();
    { pg8::Gemm g{(const bf16*)(ws + WS_U2S), (const bf16*)(ws + WS_W13), MAXSLOT, NE * 512, D, D, D}; pg8::MoeOrder<2> S; S.init((const int*)(ws + WS_TILEE), (int)gridDim.x, (int)blockIdx.x);
      pg8::EpiMoeUp E{(bf16*)(ws + WS_HS), (const float*)(ws + WS_SLOTW)};
      pg8::gemm_phase<pg8::EpiMoeUp, pg8::MoeOrder<2>, true, true>(ldsl, g, S, E); }
    GRID_BAR();
    { pg8::Gemm g{(const bf16*)(ws + WS_HS), (const bf16*)(ws + WS_W2), MAXSLOT, NE * D, DE, DE, DE}; pg8::MoeOrder<4> S; S.init((const int*)(ws + WS_TILEE), (int)gridDim.x, (int)blockIdx.x);
      pg8::EpiBf16<0> E{(bf16*)(ws + WS_YS), D, nullptr, D, 0, 1.f};
      pg8::gemm_phase<pg8::EpiBf16<0>, pg8::MoeOrder<4>, false, true>(ldsl, g, S, E); }
    GRID_BAR();
    ph_final_slots(V1, (const bf16*)(ws + WS_YS), (const int*)(ws + WS_TOKS), ada, (const float*)args.in[I_LN2W], (const float*)args.in[I_LN2B], args.out);
#undef GRID_BAR
}

extern "C" void kernel_launch(void* const* d_in, const int* in_sizes, int n_in, void* d_out, int out_size, void* d_ws, size_t ws_size, hipStream_t stream) {
    static int grid = 0;
    if (grid == 0) {
        if (n_in != 21 || in_sizes[0] != T * D || out_size != T * D || ws_size < WS_END) { fprintf(stderr, "kernel_launch: unexpected shapes (n_in %d, in0 %d, out %d, ws %zu)\n", n_in, n_in > 0 ? in_sizes[0] : -1, out_size, ws_size); grid = -1; return; }
        if (hipFuncSetAttribute((const void*)mk_fwd, hipFuncAttributeMaxDynamicSharedMemorySize, LDS_BYTES) != hipSuccess) { fprintf(stderr, "kernel_launch: hipFuncSetAttribute failed\n"); grid = -1; return; }
        int dev = 0, cus = 0, per_cu = 0;
        if (hipGetDevice(&dev) != hipSuccess || hipDeviceGetAttribute(&cus, hipDeviceAttributeMultiprocessorCount, dev) != hipSuccess) { grid = -1; return; }
        if (hipOccupancyMaxActiveBlocksPerMultiprocessor(&per_cu, (const void*)mk_fwd, NTHR, LDS_BYTES) != hipSuccess || per_cu < 1) { fprintf(stderr, "kernel_launch: occupancy query says %d blocks per CU\n", per_cu); (void)hipGetLastError(); per_cu = 1; }
        grid = cus;
        if (grid > NWG) grid = NWG;
    }
    if (grid < 0) return;
    Args a{};
    for (int i = 0; i < 21; ++i) a.in[i] = d_in[i];
    a.out = (float*)d_out; a.ws = (unsigned char*)d_ws;
    if (hipMemsetAsync((char*)d_ws + WS_CTL, 0, CTL_ZERO_BYTES, stream) != hipSuccess) { fprintf(stderr, "kernel_launch: hipMemsetAsync failed\n"); return; }
    a.ph_lo = 0; a.ph_hi = N_PHASES; a.li = 0;
    hipLaunchKernelGGL(mk_fwd, dim3(grid), dim3(NTHR), LDS_BYTES, stream, a);
}
```

```cpp
#include <hip/hip_runtime.h>
#include <cstdio>
#include <cstdint>

constexpr int NB = 8, SEQ = 2048, D = 1024, T = NB * SEQ;
constexpr int RW = 512, PW = 512, RH = 4, RD = 128;
constexpr int INC = 2560;
constexpr int NGRP = 4, EPG = 8, NE = 32, DE = 256;
constexpr int ADA = 6 * D;
constexpr float ALPHA = 1.189207115002721f;
constexpr float LN_EPS = 1e-5f;
constexpr int NWG = 256, NTHR = 512;

constexpr size_t MiB = 1u << 20;
constexpr size_t WS_CTL = 0, CTL_ZERO_BYTES = 64 * 1024;
constexpr size_t WS_ADAP = 1 * MiB;
constexpr size_t WS_ADA = 2 * MiB + 512 * 1024;
constexpr size_t WS_TOKE = 3 * MiB;
constexpr size_t WS_TOKW = WS_TOKE + 128 * 1024;
constexpr size_t WS_TOKS = WS_TOKE + 256 * 1024;
constexpr size_t WS_HIST = WS_TOKE + 384 * 1024;
constexpr size_t WS_SLOTW = WS_TOKE + 512 * 1024;
constexpr size_t WS_TILEE = WS_TOKE + 768 * 1024;
constexpr size_t WS_ROT = 4 * MiB;
constexpr size_t WS_WR = 12 * MiB;
constexpr size_t WS_WPOOL = 12 * MiB + 512 * 1024;
constexpr size_t WS_WIN = 13 * MiB;
constexpr size_t WS_WOUT = 18 * MiB;
constexpr size_t WS_W13 = 20 * MiB;
constexpr size_t WS_W2 = 52 * MiB;
constexpr size_t WS_U = 68 * MiB;
constexpr size_t WS_PROJ = 100 * MiB;
constexpr size_t WS_V1 = 100 * MiB;
constexpr size_t WS_LOG = 180 * MiB;
constexpr size_t WS_KV = 180 * MiB;
constexpr size_t WS_MIX = 212 * MiB;
constexpr size_t WS_Y2 = 164 * MiB;
constexpr size_t WS_U2S = 164 * MiB;
constexpr size_t WS_HS = 68 * MiB;
constexpr size_t WS_YS = 164 * MiB;
constexpr int MAXTILES = 160, MAXSLOT = MAXTILES * 256;
constexpr size_t WS_END = 256 * MiB;

typedef unsigned short bf16;
__device__ __forceinline__ unsigned f2bf(float f) { unsigned u = __builtin_bit_cast(unsigned, f); return (u + 0x7fffu + ((u >> 16) & 1u)) >> 16; }
__device__ __forceinline__ unsigned pk2(float lo, float hi) { return f2bf(lo) | (f2bf(hi) << 16); }
__device__ __forceinline__ float bflo(unsigned u) { return __builtin_bit_cast(float, u << 16); }
__device__ __forceinline__ float bfhi(unsigned u) { return __builtin_bit_cast(float, u & 0xffff0000u); }
__device__ __forceinline__ float bf2f(bf16 h) { return __builtin_bit_cast(float, (unsigned)h << 16); }
__device__ __forceinline__ float silu_f(float x) { return x / (1.0f + expf(-x)); }
__device__ __forceinline__ float wave_sum(float v) {
#pragma unroll
    for (int o = 1; o < 64; o <<= 1) v += __shfl_xor(v, o);
    return v;
}

__device__ __forceinline__ int tid_fresh() { int t = threadIdx.x; asm volatile("" : "+v"(t)); return t; }
#ifndef USE_NAIVE_RET
#define USE_NAIVE_RET 0
#endif
#ifndef USE_NAIVE_POOL
#define USE_NAIVE_POOL 0
#endif
struct Args { const void* in[21]; float* out; unsigned char* ws; int ph_lo, ph_hi, li, pad; };
enum { I_X = 0, I_C, I_POS, I_WADA, I_BADA, I_WIN, I_GNW, I_WPOOL, I_PSCALE, I_WOUT, I_LN1W, I_LN1B, I_WGRP, I_BGRP, I_WRT, I_BRT, I_W1, I_W3, I_W2, I_LN2W, I_LN2B };

template <class Epi>
__device__ __forceinline__ void naive_gemm(float* lds, const bf16* A, int lda, const float* W, int ldw, int M, int N, int K, const Epi& epi) {
    float* As = lds;
    float* Ws = lds + 16 * 132;
    const int tid = tid_fresh(), tx = tid & 31, ty = tid >> 5;
    const int ntn = N / 128, ntiles = (M / 128) * ntn;
    for (int tile = blockIdx.x; tile < ntiles; tile += gridDim.x) {
        const int tm = tile / ntn, tn = tile % ntn, row0 = tm * 128, col0 = tn * 128;
        float acc[8][4];
#pragma unroll
        for (int i = 0; i < 8; ++i)
#pragma unroll
            for (int j = 0; j < 4; ++j) acc[i][j] = 0.f;
        for (int k0 = 0; k0 < K; k0 += 16) {
            { const int r = tid >> 2, kq = (tid & 3) * 4; const uint2 raw = *(const uint2*)(A + (size_t)(row0 + r) * lda + k0 + kq);
              As[(kq + 0) * 132 + r] = bflo(raw.x); As[(kq + 1) * 132 + r] = bfhi(raw.x); As[(kq + 2) * 132 + r] = bflo(raw.y); As[(kq + 3) * 132 + r] = bfhi(raw.y); }
            { const int k = tid >> 5, n4 = (tid & 31) * 4; *(float4*)(Ws + k * 132 + n4) = *(const float4*)(W + (size_t)(k0 + k) * ldw + col0 + n4); }
            __syncthreads();
#pragma unroll
            for (int k = 0; k < 16; ++k) {
                const float4 a0 = *(const float4*)(As + k * 132 + ty * 8), a1 = *(const float4*)(As + k * 132 + ty * 8 + 4);
                const float4 w = *(const float4*)(Ws + k * 132 + tx * 4);
                const float av[8] = {a0.x, a0.y, a0.z, a0.w, a1.x, a1.y, a1.z, a1.w};
#pragma unroll
                for (int i = 0; i < 8; ++i) { acc[i][0] += av[i] * w.x; acc[i][1] += av[i] * w.y; acc[i][2] += av[i] * w.z; acc[i][3] += av[i] * w.w; }
            }
            __syncthreads();
        }
#pragma unroll
        for (int i = 0; i < 8; ++i) epi(row0 + ty * 8 + i, col0 + tx * 4, make_float4(acc[i][0], acc[i][1], acc[i][2], acc[i][3]));
    }
}

__device__ __forceinline__ void ph_ada_partial(float* lds, const float* c, const float* w_ada, float* part) {
    const int w = blockIdx.x, tid = tid_fresh();
    if (w >= 96) return;
    const int cb = w % 12, kr = w / 12, c4 = tid & 127, ks = tid >> 7;
    float* cact = lds;
    float4* red = (float4*)(lds + 1024);
    for (int i = tid; i < 1024; i += NTHR) { const int b = i >> 7, kk = i & 127; cact[i] = silu_f(c[b * D + kr * 128 + kk]); }
    __syncthreads();
    float4 acc[8];
#pragma unroll
    for (int b = 0; b < 8; ++b) acc[b] = make_float4(0.f, 0.f, 0.f, 0.f);
    const int col = (cb * 128 + c4) * 4;
    for (int kk = 0; kk < 32; ++kk) {
        const int kl = ks * 32 + kk;
        const float4 wv = *(const float4*)(w_ada + (size_t)(kr * 128 + kl) * ADA + col);
#pragma unroll
        for (int b = 0; b < 8; ++b) { const float a = cact[b * 128 + kl]; acc[b].x += a * wv.x; acc[b].y += a * wv.y; acc[b].z += a * wv.z; acc[b].w += a * wv.w; }
    }
#pragma unroll
    for (int b = 0; b < 8; ++b) red[(ks * 8 + b) * 128 + c4] = acc[b];
    __syncthreads();
    for (int i = tid; i < 1024; i += NTHR) {
        const int b = i >> 7, cc = i & 127;
        float4 s = red[(0 * 8 + b) * 128 + cc];
#pragma unroll
        for (int q = 1; q < 4; ++q) { const float4 v = red[(q * 8 + b) * 128 + cc]; s.x += v.x; s.y += v.y; s.z += v.z; s.w += v.w; }
        *(float4*)(part + ((size_t)kr * 8 + b) * ADA + (cb * 128 + cc) * 4) = s;
    }
}
__device__ __forceinline__ void ph_rot_table(const int* pos, float2* rot) {
    const int gt = blockIdx.x * NTHR + tid_fresh(), GT = gridDim.x * NTHR;
    for (int idx = gt; idx < T * 64; idx += GT) {
        const int t = idx >> 6, i = idx & 63;
        const double inv = exp2(-(double)i * (13.287712379549449 / 64.0));
        const double ang = (double)pos[t] * inv;
        const double k = rint(ang * 0.15915494309189535);
        double r = fma(-k, 6.283185307179586, ang); r = fma(-k, 2.4492935982947064e-16, r);
        const float rf = (float)r;
        rot[idx] = make_float2(cosf(rf), sinf(rf));
    }
}
__device__ __forceinline__ void ph_ada_final_lnmod(float* lds, const float* x, const float* part, const float* b_ada, float* ada, bf16* U) {
    const int w = blockIdx.x, tid = tid_fresh(), lane = tid & 63, wave = tid >> 6, b = w >> 5;
    float* sh1 = lds; float* sc1 = lds + 1024;
    for (int j = tid; j < 2048; j += NTHR) { float s = b_ada[j]; for (int kr = 0; kr < 8; ++kr) s += part[((size_t)kr * 8 + b) * ADA + j]; if (j < 1024) sh1[j] = s; else sc1[j - 1024] = 1.0f + s; }
    { const int j0 = (w & 31) * 192; for (int j = tid; j < 192; j += NTHR) { float s = b_ada[j0 + j]; for (int kr = 0; kr < 8; ++kr) s += part[((size_t)kr * 8 + b) * ADA + j0 + j]; ada[(size_t)b * ADA + j0 + j] = s; } }
    __syncthreads();
    for (int i = 0; i < 8; ++i) {
        const int row = w * 64 + wave * 8 + i;
        const float4* xr = (const float4*)(x + (size_t)row * D) + lane;
        float4 v[4]; float s = 0.f;
#pragma unroll
        for (int j = 0; j < 4; ++j) { v[j] = xr[64 * j]; s += (v[j].x + v[j].y) + (v[j].z + v[j].w); }
        const float mean = wave_sum(s) * (1.f / D); float s2 = 0.f;
#pragma unroll
        for (int j = 0; j < 4; ++j) { v[j].x -= mean; v[j].y -= mean; v[j].z -= mean; v[j].w -= mean; s2 += (v[j].x * v[j].x + v[j].y * v[j].y) + (v[j].z * v[j].z + v[j].w * v[j].w); }
        const float rstd = 1.f / sqrtf(wave_sum(s2) * (1.f / D) + LN_EPS);
        uint2* o = (uint2*)(U + (size_t)row * D) + lane;
#pragma unroll
        for (int j = 0; j < 4; ++j) { const float4 sc = *(const float4*)(sc1 + 4 * lane + 256 * j), sh = *(const float4*)(sh1 + 4 * lane + 256 * j);
            o[64 * j] = make_uint2(pk2(v[j].x * rstd * sc.x + sh.x, v[j].y * rstd * sc.y + sh.y), pk2(v[j].z * rstd * sc.z + sh.z, v[j].w * rstd * sc.w + sh.w)); }
    }
}
__device__ __forceinline__ void ph_ret_naive(float* lds, const bf16* proj, const float2* rot, const float* gnw, bf16* mix) {
    const int w = blockIdx.x, tid = tid_fresh();
    if (w >= 32) return;
    const int b = w >> 2, h = w & 3, e = tid & 127, dg = tid >> 7;
    const float gamma = 1.0f - exp2f(-5.0f - (float)h);
    float* Q = lds;
    float* Kk = lds + 4096;
    float* V = lds + 8192;
    float* red = lds + 12288;
    float Sx[32];
#pragma unroll
    for (int i = 0; i < 32; ++i) Sx[i] = 0.f;
    for (int t0 = 0; t0 < SEQ; t0 += 32) {
        __syncthreads();
        for (int it = tid; it < 32 * 64; it += NTHR) {
            const int r = it >> 6, i = it & 63; const size_t row = (size_t)b * SEQ + t0 + r;
            const float2 cs = rot[row * 64 + i];
            const bf16* pr = proj + row * INC;
            const float q1 = bf2f(pr[h * 128 + i]), q2 = bf2f(pr[h * 128 + 64 + i]);
            const float k1 = bf2f(pr[512 + h * 128 + i]), k2 = bf2f(pr[512 + h * 128 + 64 + i]);
            Q[r * 128 + i] = q1 * cs.x - q2 * cs.y; Q[r * 128 + 64 + i] = q1 * cs.y + q2 * cs.x;
            Kk[r * 128 + i] = (k1 * cs.x - k2 * cs.y) * 0.08838834764831845f; Kk[r * 128 + 64 + i] = (k1 * cs.y + k2 * cs.x) * 0.08838834764831845f;
            V[r * 128 + i] = bf2f(pr[1024 + h * 128 + i]); V[r * 128 + 64 + i] = bf2f(pr[1024 + h * 128 + 64 + i]);
        }
        __syncthreads();
        for (int r = 0; r < 32; ++r) {
            const float ve = V[r * 128 + e]; float o = 0.f;
#pragma unroll
            for (int dd = 0; dd < 32; ++dd) { const int d = dg * 32 + dd; Sx[dd] = gamma * Sx[dd] + Kk[r * 128 + d] * ve; o += Q[r * 128 + d] * Sx[dd]; }
            red[(r * 4 + dg) * 128 + e] = o;
        }
        __syncthreads();
        { const int lane = tid & 63, wave = tid >> 6;
          for (int rr = 0; rr < 4; ++rr) { const int r = wave * 4 + rr; const size_t row = (size_t)b * SEQ + t0 + r;
              float v0 = 0.f, v1 = 0.f;
#pragma unroll
              for (int q = 0; q < 4; ++q) { v0 += red[(r * 4 + q) * 128 + lane]; v1 += red[(r * 4 + q) * 128 + 64 + lane]; }
              const float mean = wave_sum(v0 + v1) * (1.f / 128.f); v0 -= mean; v1 -= mean;
              const float rstd = 1.f / sqrtf(wave_sum(v0 * v0 + v1 * v1) * (1.f / 128.f) + LN_EPS);
              const bf16* pr = proj + row * INC + 1536 + h * 128;
              const float g0 = bf2f(pr[lane]), g1 = bf2f(pr[64 + lane]);
              bf16* mo = mix + row * D + h * 128;
              mo[lane] = (bf16)f2bf(silu_f(g0) * (v0 * rstd * gnw[h * 128 + lane])); mo[64 + lane] = (bf16)f2bf(silu_f(g1) * (v1 * rstd * gnw[h * 128 + 64 + lane])); } }
    }
}
__device__ __forceinline__ void ph_pool_naive(float* lds, const bf16* proj, const float* w_pool, const float* pscale, bf16* mix) {
    const int tid = tid_fresh();
    float* P = lds;
    for (int unit = blockIdx.x; unit < 256 * 4; unit += gridDim.x) {
        const int rb = unit >> 2, g = unit & 3, win = 2 << g, row0 = rb * 64;
        __syncthreads();
        for (int it = tid; it < 64 * 128; it += NTHR) {
            const int r = it >> 7, cc = it & 127; const int row = row0 + r, s = row & (SEQ - 1);
            const int cnt = (s + 1 < win) ? (s + 1) : win;
            float sum = 0.f;
            for (int j = 0; j < cnt; ++j) sum += bf2f(proj[(size_t)(row - j) * INC + 2048 + g * 128 + cc]);
            P[it] = sum / (float)cnt - bf2f(proj[(size_t)row * INC + 2048 + g * 128 + cc]);
        }
        __syncthreads();
        const int d = tid & 127, rg = tid >> 7;
        float acc[16];
#pragma unroll
        for (int i = 0; i < 16; ++i) acc[i] = 0.f;
        for (int cc = 0; cc < 128; ++cc) { const float wv = w_pool[((size_t)g * 128 + cc) * 128 + d];
#pragma unroll
            for (int i = 0; i < 16; ++i) acc[i] += P[(rg * 16 + i) * 128 + cc] * wv; }
        const float ps = pscale[g * 128 + d];
#pragma unroll
        for (int i = 0; i < 16; ++i) mix[(size_t)(row0 + rg * 16 + i) * D + 512 + g * 128 + d] = (bf16)f2bf(acc[i] * ps);
    }
}
__device__ __forceinline__ void ph_ln1_ln2mod(float* V1, const float* ln1w, const float* ln1b, const float* ada, bf16* U2) {
    const int tid = tid_fresh(), lane = tid & 63, wave = tid >> 6;
    for (int row = blockIdx.x * 8 + wave; row < T; row += gridDim.x * 8) {
        const int b = row / SEQ;
        float4* xr = (float4*)(V1 + (size_t)row * D) + lane;
        float4 v[4]; float s = 0.f;
#pragma unroll
        for (int j = 0; j < 4; ++j) { v[j] = xr[64 * j]; s += (v[j].x + v[j].y) + (v[j].z + v[j].w); }
        float mean = wave_sum(s) * (1.f / D); float s2 = 0.f;
#pragma unroll
        for (int j = 0; j < 4; ++j) { v[j].x -= mean; v[j].y -= mean; v[j].z -= mean; v[j].w -= mean; s2 += (v[j].x * v[j].x + v[j].y * v[j].y) + (v[j].z * v[j].z + v[j].w * v[j].w); }
        float rstd = 1.f / sqrtf(wave_sum(s2) * (1.f / D) + LN_EPS);
        s = 0.f;
#pragma unroll
        for (int j = 0; j < 4; ++j) { const float4 lw = *((const float4*)ln1w + lane + 64 * j), lb = *((const float4*)ln1b + lane + 64 * j);
            v[j].x = v[j].x * rstd * lw.x + lb.x; v[j].y = v[j].y * rstd * lw.y + lb.y; v[j].z = v[j].z * rstd * lw.z + lb.z; v[j].w = v[j].w * rstd * lw.w + lb.w;
            xr[64 * j] = v[j]; s += (v[j].x + v[j].y) + (v[j].z + v[j].w); }
        mean = wave_sum(s) * (1.f / D); s2 = 0.f;
#pragma unroll
        for (int j = 0; j < 4; ++j) { v[j].x -= mean; v[j].y -= mean; v[j].z -= mean; v[j].w -= mean; s2 += (v[j].x * v[j].x + v[j].y * v[j].y) + (v[j].z * v[j].z + v[j].w * v[j].w); }
        rstd = 1.f / sqrtf(wave_sum(s2) * (1.f / D) + LN_EPS);
        const float* sh2 = ada + (size_t)b * ADA + 3 * D; const float* sc2 = ada + (size_t)b * ADA + 4 * D;
        uint2* o = (uint2*)(U2 + (size_t)row * D) + lane;
#pragma unroll
        for (int j = 0; j < 4; ++j) { const float4 sc = *((const float4*)sc2 + lane + 64 * j), sh = *((const float4*)sh2 + lane + 64 * j);
            o[64 * j] = make_uint2(pk2(v[j].x * rstd * (1.f + sc.x) + sh.x, v[j].y * rstd * (1.f + sc.y) + sh.y), pk2(v[j].z * rstd * (1.f + sc.z) + sh.z, v[j].w * rstd * (1.f + sc.w) + sh.w)); }
    }
}
__device__ __forceinline__ void ph_router_naive(float* lds, const bf16* U2, const float* wg, const float* wr, float* logits) {
    const int tid = tid_fresh(), tl = tid >> 3, jg = tid & 7;
    float* Wl = lds;
    for (int blk = blockIdx.x; blk < T / 64; blk += gridDim.x) {
        const int t = blk * 64 + tl;
        float acc[5] = {0.f, 0.f, 0.f, 0.f, 0.f};
        for (int kh = 0; kh < 2; ++kh) {
            __syncthreads();
            for (int it = tid; it < 512 * 36; it += NTHR) { const int k = it / 36, j = it % 36; Wl[it] = (j < 4) ? wg[(size_t)(kh * 512 + k) * 4 + j] : wr[(size_t)(kh * 512 + k) * 32 + (j - 4)]; }
            __syncthreads();
            for (int k = 0; k < 512; ++k) { const float u = bf2f(U2[(size_t)t * D + kh * 512 + k]);
#pragma unroll
                for (int i = 0; i < 5; ++i) { const int j = jg + 8 * i; if (j < 36) acc[i] += u * Wl[k * 36 + j]; } }
        }
#pragma unroll
        for (int i = 0; i < 5; ++i) { const int j = jg + 8 * i; if (j < 36) logits[(size_t)t * 64 + j] = acc[i]; }
    }
}
__device__ __forceinline__ void ph_route(const float* logits, int npart, const float* bg, const float* br, int* tok_e, float* tok_w) {
    const int gt = blockIdx.x * NTHR + tid_fresh(), GT = gridDim.x * NTHR;
    for (int t = gt; t < T; t += GT) {
        float gl[4];
#pragma unroll
        for (int j = 0; j < 4; ++j) { float s = bg[j]; for (int p = 0; p < npart; ++p) s += logits[((size_t)p * T + t) * 64 + j]; gl[j] = s; }
        int gi = 0; float gm = gl[0];
#pragma unroll
        for (int j = 1; j < 4; ++j) if (gl[j] > gm) { gm = gl[j]; gi = j; }
        float den = 0.f;
#pragma unroll
        for (int j = 0; j < 4; ++j) den += expf(gl[j] - gm);
        const float gprob = 1.0f / den;
        float el[8];
#pragma unroll
        for (int i = 0; i < 8; ++i) { float s = 0.f; for (int p = 0; p < npart; ++p) s += logits[((size_t)p * T + t) * 64 + 4 + gi * 8 + i]; el[i] = s + br[gi * 8 + i]; }
        int i0 = 0; float v0 = el[0];
#pragma unroll
        for (int i = 1; i < 8; ++i) if (el[i] > v0) { v0 = el[i]; i0 = i; }
        int i1 = -1; float v1 = 0.f;
#pragma unroll
        for (int i = 0; i < 8; ++i) if (i != i0 && (i1 < 0 || el[i] > v1)) { v1 = el[i]; i1 = i; }
        const float ex = expf(v1 - v0), inv = 1.0f / (1.0f + ex);
        tok_e[2 * t] = gi * 8 + i0; tok_e[2 * t + 1] = gi * 8 + i1;
        tok_w[2 * t] = gprob * inv; tok_w[2 * t + 1] = gprob * ex * inv;
    }
}
__device__ __forceinline__ void ph_moe_naive(float* lds, const bf16* U2, const int* tok_e, const float* tok_w, const float* w1, const float* w3, const float* w2, float* Y2) {
    const int tid = tid_fresh();
    float* u = lds;
    float* pa = lds + 1024;
    float* pb = lds + 1536;
    float* hh = lds + 2048;
    for (int t = blockIdx.x; t < T; t += gridDim.x) {
        __syncthreads();
        for (int i = tid; i < D; i += NTHR) u[i] = bf2f(U2[(size_t)t * D + i]);
        float y0 = 0.f, y1 = 0.f;
        for (int k = 0; k < 2; ++k) {
            const int e = tok_e[2 * t + k]; const float wgt = tok_w[2 * t + k];
            __syncthreads();
            { const int f = tid & 255, hf = tid >> 8; const float* p1 = w1 + ((size_t)e * D + hf * 512) * DE + f; const float* p3 = w3 + ((size_t)e * D + hf * 512) * DE + f;
              float a = 0.f, bq = 0.f;
              for (int d = 0; d < 512; ++d) { const float uv = u[hf * 512 + d]; a += uv * p1[(size_t)d * DE]; bq += uv * p3[(size_t)d * DE]; }
              pa[hf * 256 + f] = a; pb[hf * 256 + f] = bq; }
            __syncthreads();
            if (tid < 256) { const float a = pa[tid] + pa[256 + tid], bq = pb[tid] + pb[256 + tid]; hh[tid] = silu_f(a) * bq * wgt; }
            __syncthreads();
            { const float* p2 = w2 + (size_t)e * DE * D + tid;
              for (int f = 0; f < 256; ++f) { const float hv = hh[f]; y0 += hv * p2[(size_t)f * D]; y1 += hv * p2[(size_t)f * D + 512]; } }
        }
        Y2[(size_t)t * D + tid] = y0; Y2[(size_t)t * D + 512 + tid] = y1;
    }
}
__device__ __forceinline__ void ph_final(const float* X1, const float* Y2, const float* ada, const float* ln2w, const float* ln2b, float* out) {
    const int tid = tid_fresh(), lane = tid & 63, wave = tid >> 6;
    for (int row = blockIdx.x * 8 + wave; row < T; row += gridDim.x * 8) {
        const int b = row / SEQ;
        const float4* xr = (const float4*)(X1 + (size_t)row * D) + lane; const float4* yr = (const float4*)(Y2 + (size_t)row * D) + lane;
        const float4* g2 = (const float4*)(ada + (size_t)b * ADA + 5 * D) + lane;
        float4 v[4]; float s = 0.f;
#pragma unroll
        for (int j = 0; j < 4; ++j) { const float4 xv = xr[64 * j], yv = yr[64 * j], gv = g2[64 * j];
            v[j].x = ALPHA * xv.x + gv.x * yv.x; v[j].y = ALPHA * xv.y + gv.y * yv.y; v[j].z = ALPHA * xv.z + gv.z * yv.z; v[j].w = ALPHA * xv.w + gv.w * yv.w; s += (v[j].x + v[j].y) + (v[j].z + v[j].w); }
        const float mean = wave_sum(s) * (1.f / D); float s2 = 0.f;
#pragma unroll
        for (int j = 0; j < 4; ++j) { v[j].x -= mean; v[j].y -= mean; v[j].z -= mean; v[j].w -= mean; s2 += (v[j].x * v[j].x + v[j].y * v[j].y) + (v[j].z * v[j].z + v[j].w * v[j].w); }
        const float rstd = 1.f / sqrtf(wave_sum(s2) * (1.f / D) + LN_EPS);
        float4* o = (float4*)(out + (size_t)row * D) + lane;
#pragma unroll
        for (int j = 0; j < 4; ++j) { const float4 lw = *((const float4*)ln2w + lane + 64 * j), lb = *((const float4*)ln2b + lane + 64 * j);
            o[64 * j] = make_float4(v[j].x * rstd * lw.x + lb.x, v[j].y * rstd * lw.y + lb.y, v[j].z * rstd * lw.z + lb.z, v[j].w * rstd * lw.w + lb.w); }
    }
}


__device__ __forceinline__ void ph_route_hist(float* lds, const float* logits, int npart, const float* bg, const float* br, int* tok_e, float* tok_w, int* hist) {
    const int tid = tid_fresh(); int* h = (int*)lds;
    for (int blk = blockIdx.x; blk < T / 64; blk += gridDim.x) {
        __syncthreads();
        if (tid < 32) h[tid] = 0;
        __syncthreads();
        if (tid < 64) {
            const int t = blk * 64 + tid;
            float gl[4];
#pragma unroll
            for (int j = 0; j < 4; ++j) { float s = bg[j]; for (int p = 0; p < npart; ++p) s += logits[((size_t)p * T + t) * 64 + j]; gl[j] = s; }
            int gi = 0; float gm = gl[0];
#pragma unroll
            for (int j = 1; j < 4; ++j) if (gl[j] > gm) { gm = gl[j]; gi = j; }
            float den = 0.f;
#pragma unroll
            for (int j = 0; j < 4; ++j) den += expf(gl[j] - gm);
            const float gprob = 1.0f / den;
            float el[8];
#pragma unroll
            for (int i = 0; i < 8; ++i) { float s = 0.f; for (int p = 0; p < npart; ++p) s += logits[((size_t)p * T + t) * 64 + 4 + gi * 8 + i]; el[i] = s + br[gi * 8 + i]; }
            int i0 = 0; float v0 = el[0];
#pragma unroll
            for (int i = 1; i < 8; ++i) if (el[i] > v0) { v0 = el[i]; i0 = i; }
            int i1 = -1; float v1 = 0.f;
#pragma unroll
            for (int i = 0; i < 8; ++i) if (i != i0 && (i1 < 0 || el[i] > v1)) { v1 = el[i]; i1 = i; }
            const float ex = expf(v1 - v0), inv = 1.0f / (1.0f + ex);
            tok_e[2 * t] = gi * 8 + i0; tok_e[2 * t + 1] = gi * 8 + i1;
            tok_w[2 * t] = gprob * inv; tok_w[2 * t + 1] = gprob * ex * inv;
            atomicAdd(&h[gi * 8 + i0], 1); atomicAdd(&h[gi * 8 + i1], 1);
        }
        __syncthreads();
        if (tid < 32) hist[blk * 32 + tid] = h[tid];
    }
}
__device__ __forceinline__ void ph_permute(float* lds, const int* hist, const int* tok_e, const float* tok_w, const bf16* U2, int* tok_slot, float* slot_w, int* tile_e, bf16* U2s) {
    const int tid = tid_fresh(), lane = tid & 63, wave = tid >> 6;
    int* cnt = (int*)lds; int* pre = cnt + 32; int* base = cnt + 64; int* ee = cnt + 128; int* ss = cnt + 256;
    for (int blk = blockIdx.x; blk < T / 64; blk += gridDim.x) {
        __syncthreads();
        if (tid < 32) { int c = 0, p = 0; for (int w = 0; w < T / 64; ++w) { const int v = hist[w * 32 + tid]; c += v; if (w < blk) p += v; } cnt[tid] = c; pre[tid] = p; }
        if (tid >= 64 && tid < 192) ee[tid - 64] = tok_e[blk * 128 + (tid - 64)];
        __syncthreads();
        if (tid == 0) { int b = 0; for (int e = 0; e < 32; ++e) { base[e] = b; b += (cnt[e] + 255) & ~255; } base[32] = b; }
        __syncthreads();
        if (tid < 128) { const int e = ee[tid]; int rank = 0; for (int j = 0; j < tid; ++j) rank += (ee[j] == e) ? 1 : 0;
            const int slot = base[e] + pre[e] + rank; ss[tid] = slot; tok_slot[blk * 128 + tid] = slot; slot_w[slot] = tok_w[blk * 128 + tid]; }
        if (blk == 0 && tid >= 256 && tid < 256 + 32) { const int e = tid - 256; const int t0 = base[e] >> 8, t1 = base[e + 1] >> 8; for (int q = t0; q < t1; ++q) tile_e[q] = e; if (e == 0) tile_e[MAXTILES] = base[32] >> 8; }
        __syncthreads();
        for (int i = wave; i < 128; i += 8) { const int t = blk * 64 + (i >> 1); const uint4* s = (const uint4*)(U2 + (size_t)t * D); uint4* d = (uint4*)(U2s + (size_t)ss[i] * D);
            d[lane] = s[lane]; d[lane + 64] = s[lane + 64]; }
    }
}
__device__ __forceinline__ void ph_final_slots(const float* X1, const bf16* Ys, const int* tok_slot, const float* ada, const float* ln2w, const float* ln2b, float* out) {
    const int tid = tid_fresh(), lane = tid & 63, wave = tid >> 6;
    for (int row = blockIdx.x * 8 + wave; row < T; row += gridDim.x * 8) {
        const int b = row / SEQ; const int s0 = tok_slot[2 * row], s1 = tok_slot[2 * row + 1];
        const float4* xr = (const float4*)(X1 + (size_t)row * D) + lane;
        const uint2* y0 = (const uint2*)(Ys + (size_t)s0 * D) + lane; const uint2* y1 = (const uint2*)(Ys + (size_t)s1 * D) + lane;
        const float4* g2 = (const float4*)(ada + (size_t)b * ADA + 5 * D) + lane;
        float4 v[4]; float s = 0.f;
#pragma unroll
        for (int j = 0; j < 4; ++j) { const float4 xv = xr[64 * j], gv = g2[64 * j]; const uint2 a = y0[64 * j], c = y1[64 * j];
            v[j].x = ALPHA * xv.x + gv.x * (bflo(a.x) + bflo(c.x)); v[j].y = ALPHA * xv.y + gv.y * (bfhi(a.x) + bfhi(c.x));
            v[j].z = ALPHA * xv.z + gv.z * (bflo(a.y) + bflo(c.y)); v[j].w = ALPHA * xv.w + gv.w * (bfhi(a.y) + bfhi(c.y)); s += (v[j].x + v[j].y) + (v[j].z + v[j].w); }
        const float mean = wave_sum(s) * (1.f / D); float s2 = 0.f;
#pragma unroll
        for (int j = 0; j < 4; ++j) { v[j].x -= mean; v[j].y -= mean; v[j].z -= mean; v[j].w -= mean; s2 += (v[j].x * v[j].x + v[j].y * v[j].y) + (v[j].z * v[j].z + v[j].w * v[j].w); }
        const float rstd = 1.f / sqrtf(wave_sum(s2) * (1.f / D) + LN_EPS);
        float4* o = (float4*)(out + (size_t)row * D) + lane;
#pragma unroll
        for (int j = 0; j < 4; ++j) { const float4 lw = *((const float4*)ln2w + lane + 64 * j), lb = *((const float4*)ln2b + lane + 64 * j);
            o[64 * j] = make_float4(v[j].x * rstd * lw.x + lb.x, v[j].y * rstd * lw.y + lb.y, v[j].z * rstd * lw.z + lb.z, v[j].w * rstd * lw.w + lb.w); }
    }
}

struct EpiStoreBf16 { bf16* O; int ldc; __device__ __forceinline__ void operator()(int row, int col, float4 a) const { *(uint2*)(O + (size_t)row * ldc + col) = make_uint2(pk2(a.x, a.y), pk2(a.z, a.w)); } };
struct EpiV1 { const float* x; const float* ada; float* V1;
    __device__ __forceinline__ void operator()(int row, int col, float4 a) const { const int b = row / SEQ; const float4 xv = *(const float4*)(x + (size_t)row * D + col), g = *(const float4*)(ada + (size_t)b * ADA + 2 * D + col);
        *(float4*)(V1 + (size_t)row * D + col) = make_float4(ALPHA * xv.x + g.x * a.x, ALPHA * xv.y + g.y * a.y, ALPHA * xv.z + g.z * a.z, ALPHA * xv.w + g.w * a.w); } };


namespace pg8 {
#define PG8_LAS __attribute__((address_space(3)))
typedef unsigned short bf16_t;
typedef short bf16x8 __attribute__((ext_vector_type(8)));
typedef float f32x4 __attribute__((ext_vector_type(4)));
typedef unsigned u32x4 __attribute__((ext_vector_type(4)));
constexpr int BM = 256, BK = 64, HALF = 128, HTB = HALF * BK * 2  , STAGE_BYTES = 8 * HTB, NXCD = 8, WGM = 8;

__host__ __device__ __forceinline__ int lds_byte(int r, int c) { const int st = (r >> 4) * 2 + (c >> 5), rr = r & 15, cc = c & 31, ob = rr * 64 + cc * 2; return st * 1024 + (ob ^ (((ob >> 9) & 1) << 5)); }
__host__ __device__ __forceinline__ void stage_rc(int b, int& R, int& C) { const int st = b / 1024, sb = b % 1024, swz = sb ^ (((sb >> 9) & 1) << 5); R = (st >> 1) * 16 + swz / 64; C = (st & 1) * 32 + (swz % 64) / 2; }
__host__ __device__ __forceinline__ int perm32(int rho) { const int n = rho >> 4, i = rho & 15; return 8 * (i >> 2) + 4 * n + (i & 3); }

struct Unit { int pm, pn, ka; };
struct Gemm { const bf16_t* A; const bf16_t* Bt; int M, N, K, lda, ldb; };

struct StaticOrder {
    int nM, nN, nwg, G, c;
    __host__ __device__ void init(int M, int N, int G_, int c_) { nM = M / BM; nN = N / BM; nwg = nM * nN; G = G_; c = c_; }
    __host__ __device__ bool next(int i, Unit& u) const {
        const long L = (long)i * G + c; if (L >= nwg) return false;
        int wgid = (int)L; { const int q = nwg / NXCD, r = nwg % NXCD, xcd = wgid % NXCD, off = wgid / NXCD; wgid = (xcd < r ? xcd * (q + 1) : r * (q + 1) + (xcd - r) * q) + off; }
        const int nig = WGM * nN, gid = wgid / nig, fm = gid * WGM, gsz = (nM - fm) < WGM ? (nM - fm) : WGM;
        u.pm = fm + ((wgid % nig) % gsz); u.pn = (wgid % nig) / gsz; u.ka = 0; return true;
    }
    __device__ __forceinline__ void a_ready(const Unit&) const {}
    __device__ __forceinline__ void done(const Unit&) const {}
};

__device__ __forceinline__ unsigned cvt_pk_bf16(float lo, float hi) { unsigned r; asm volatile("v_cvt_pk_bf16_f32 %0, %1, %2" : "=v"(r) : "v"(lo), "v"(hi)); return r; }
typedef float f32x2 __attribute__((ext_vector_type(2)));
__device__ __forceinline__ f32x2 gelu_pk(f32x2 v) { return v; }
template <int ACT  > struct EpiBf16 {
    static constexpr bool PERM = true, AFTER_DRAIN = false; static_assert(ACT == 0 || ACT == 1, "EpiBf16: ACT is 0 (none) or 1 (gelu_pk)");
    bf16_t* O; int ldc; const float* bias; int split_cols; size_t split_stride; float scale0;
    __device__ __forceinline__ void operator()(const f32x4 (&acc)[2][2][4][2], const Unit& u, int wr, int wc, int fr, int fq) const {
        const int row0 = u.pm * BM + wr * 64 + fr; int colt = u.pn * BM; bf16_t* base = O;
        float sc = 1.f; if (split_cols) { const int t = colt / split_cols; base += (size_t)t * split_stride; colt -= t * split_cols; if (t == 0) sc = scale0; }
        const int col0 = colt + wc * 32 + 8 * fq, bcol0 = u.pn * BM + wc * 32 + 8 * fq;
        f32x4 bv[2][2];
#pragma unroll
        for (int bj = 0; bj < 2; ++bj)
#pragma unroll
            for (int n = 0; n < 2; ++n) bv[bj][n] = bias ? *(const f32x4*)(bias + bcol0 + bj * HALF + 4 * n) : (f32x4){0.f, 0.f, 0.f, 0.f};
#pragma unroll
        for (int ai = 0; ai < 2; ++ai)
#pragma unroll
            for (int m = 0; m < 4; ++m) { bf16_t* rowp = base + (size_t)(row0 + ai * HALF + m * 16) * ldc + col0;
#pragma unroll
                for (int bj = 0; bj < 2; ++bj) { f32x4 v0 = acc[ai][bj][m][0] + bv[bj][0], v1 = acc[ai][bj][m][1] + bv[bj][1];
                    if (ACT == 1) { f32x2 a = gelu_pk((f32x2){v0[0], v0[1]}), b = gelu_pk((f32x2){v0[2], v0[3]}), c = gelu_pk((f32x2){v1[0], v1[1]}), d = gelu_pk((f32x2){v1[2], v1[3]});
                        v0 = (f32x4){a.x, a.y, b.x, b.y}; v1 = (f32x4){c.x, c.y, d.x, d.y}; }
                    v0 = v0 * sc; v1 = v1 * sc; u32x4 w; w.x = cvt_pk_bf16(v0[0], v0[1]); w.y = cvt_pk_bf16(v0[2], v0[3]); w.z = cvt_pk_bf16(v1[0], v1[1]); w.w = cvt_pk_bf16(v1[2], v1[3]);
                    *(u32x4*)(rowp + bj * HALF) = w; } }
    }
};

struct EpiV1f {
    static constexpr bool PERM = false, AFTER_DRAIN = false;
    const float* x; const float* ada; float* V1;
    __device__ __forceinline__ void operator()(const f32x4 (&acc)[2][2][4][2], const Unit& u, int wr, int wc, int fr, int fq) const {
        const int row0 = u.pm * BM + wr * 64 + fr, col0 = u.pn * BM + wc * 32 + 4 * fq; const int b = (u.pm * BM) / 2048;
        f32x4 gv[2][2];
#pragma unroll
        for (int bj = 0; bj < 2; ++bj)
#pragma unroll
            for (int n = 0; n < 2; ++n) gv[bj][n] = *(const f32x4*)(ada + (size_t)b * 6144 + 2048 + col0 + bj * HALF + n * 16);
#pragma unroll
        for (int ai = 0; ai < 2; ++ai)
#pragma unroll
            for (int m = 0; m < 4; ++m) { const size_t off = (size_t)(row0 + ai * HALF + m * 16) * 1024 + col0;
#pragma unroll
                for (int bj = 0; bj < 2; ++bj)
#pragma unroll
                    for (int n = 0; n < 2; ++n) { const f32x4 xv = *(const f32x4*)(x + off + bj * HALF + n * 16);
                        *(f32x4*)(V1 + off + bj * HALF + n * 16) = xv * 1.189207115002721f + gv[bj][n] * acc[ai][bj][m][n]; } }
    }
};


template <int NSUB> struct MoeOrder {
    const int* tile_e; int nunits, G, c;
    __device__ void init(const int* te, int G_, int c_) { tile_e = te; nunits = te[160] * NSUB; G = G_; c = c_; }
    __device__ bool next(int i, Unit& u) const { const int L = i * G + c; if (L >= nunits) return false; u.pm = L / NSUB; u.pn = tile_e[u.pm] * NSUB + (L % NSUB); u.ka = 0; return true; }
    __device__ __forceinline__ void a_ready(const Unit&) const {}
    __device__ __forceinline__ void done(const Unit&) const {}
};
struct EpiMoeUp {
    static constexpr bool PERM = true, AFTER_DRAIN = false;
    bf16_t* Hs; const float* slot_w;
    __device__ __forceinline__ void operator()(const f32x4 (&acc)[2][2][4][2], const Unit& u, int wr, int wc, int fr, int fq) const {
        const int row0 = u.pm * BM + wr * 64 + fr, col0 = (u.pn & 1) * HALF + wc * 32 + 8 * fq;
#pragma unroll
        for (int ai = 0; ai < 2; ++ai)
#pragma unroll
            for (int m = 0; m < 4; ++m) { const int slot = row0 + ai * HALF + m * 16; const float w = slot_w[slot];
                float hv[8];
#pragma unroll
                for (int n = 0; n < 2; ++n)
#pragma unroll
                    for (int j = 0; j < 4; ++j) { const float a = acc[ai][0][m][n][j], b = acc[ai][1][m][n][j]; hv[4 * n + j] = a * __builtin_amdgcn_rcpf(1.0f + __builtin_amdgcn_exp2f(-1.4426950408889634f * a)) * b * w; }
                u32x4 o; o.x = cvt_pk_bf16(hv[0], hv[1]); o.y = cvt_pk_bf16(hv[2], hv[3]); o.z = cvt_pk_bf16(hv[4], hv[5]); o.w = cvt_pk_bf16(hv[6], hv[7]);
                *(u32x4*)(Hs + (size_t)slot * 256 + col0) = o; }
    }
};

template <class Epi, class Sched, bool ALIGN_EPI = false, bool SP2 = false>
__device__ __forceinline__ void gemm_phase(PG8_LAS unsigned char* lds, const Gemm g, const Sched& S, const Epi& E) {
    const int tid = tid_fresh(), wid = __builtin_amdgcn_readfirstlane(tid >> 6), lane = tid & 63, wr = wid >> 2, wc = wid & 3, fr = lane & 15, fq = lane >> 4;
    const int K = g.K, nt = K / BK;
    unsigned voffA[2], voffB[2];
#pragma unroll
    for (int i = 0; i < 2; ++i) { int R, C; stage_rc(tid * 16 + i * 8192, R, C); const int Rb = Epi::PERM ? ((R & ~31) + perm32(R & 31)) : R;
        voffA[i] = (unsigned)(R * g.lda + C) * 2u; voffB[i] = (unsigned)(Rb * g.ldb + C) * 2u; }
    const size_t kstep = (size_t)(BK * 2);
    const size_t hstepA = (size_t)HALF * g.lda * 2, hstepB = (size_t)HALF * g.ldb * 2;
    const size_t tstepA = 2 * hstepA, tstepB = 2 * hstepB;
    const unsigned ldsw = (unsigned)wid * 1024u;
    const int aoff = lds_byte(wr * 64 + fr, fq * 8), boff = lds_byte(wc * 32 + fr, fq * 8);
#define PG8_SA(b, h) (((b) * 2 + (h)) * HTB)
#define PG8_SB(b, h) ((4 + (b) * 2 + (h)) * HTB)
#define PG8_STAGE(bufoff, gbase, voff) do { _Pragma("unroll") for (int _i = 0; _i < 2; ++_i) \
        __builtin_amdgcn_global_load_lds((const unsigned*)((const char*)(gbase) + (voff)[_i]), (PG8_LAS unsigned*)(lds + (bufoff) + ldsw + _i * 8192), 16, 0, 0); } while (0)
#define PG8_LDA(dst, b, h) do { _Pragma("unroll") for (int m = 0; m < 4; ++m) _Pragma("unroll") for (int k = 0; k < 2; ++k) dst[m][k] = *(const PG8_LAS bf16x8*)(lds + PG8_SA(b, h) + aoff + m * 2048 + k * 1024); } while (0)
#define PG8_LDB(dst, b, h) do { _Pragma("unroll") for (int n = 0; n < 2; ++n) _Pragma("unroll") for (int k = 0; k < 2; ++k) dst[n][k] = *(const PG8_LAS bf16x8*)(lds + PG8_SB(b, h) + boff + n * 2048 + k * 1024); } while (0)
#define PG8_MMA(ai, bj, At, Bt) do { __builtin_amdgcn_s_setprio(1); _Pragma("unroll") for (int m = 0; m < 4; ++m) _Pragma("unroll") for (int n = 0; n < 2; ++n) _Pragma("unroll") for (int k = 0; k < 2; ++k) \
        acc[ai][bj][m][n] = __builtin_amdgcn_mfma_f32_16x16x32_bf16(Bt[n][k], At[m][k], acc[ai][bj][m][n], 0, 0, 0); __builtin_amdgcn_s_setprio(0); } while (0)
#define PG8_WAIT_V(n) asm volatile("s_waitcnt vmcnt(" #n ")" ::: "memory")
#define PG8_WAIT_L(n) asm volatile("s_waitcnt lgkmcnt(" #n ")" ::: "memory")
#define PG8_BAR __builtin_amdgcn_s_barrier()
#define PG8_SCHED __builtin_amdgcn_sched_barrier(0)
    Unit cur, nxt; int ui = 0;
    if (!S.next(0, cur)) return;
    f32x4 acc[2][2][4][2];
#pragma unroll
    for (int a = 0; a < 2; ++a)
#pragma unroll
        for (int b = 0; b < 2; ++b)
#pragma unroll
            for (int m = 0; m < 4; ++m)
#pragma unroll
                for (int n = 0; n < 2; ++n) acc[a][b][m][n] = (f32x4){0.f, 0.f, 0.f, 0.f};
    bf16x8 At[4][2], B0[2][2], B1[2][2];
    const char* cA = (const char*)g.A + (size_t)cur.pm * tstepA + (size_t)cur.ka * 2; const char* cB = (const char*)g.Bt + (size_t)cur.pn * tstepB + (size_t)cur.ka * 2;
    S.a_ready(cur);
    if constexpr (SP2) {
        PG8_STAGE(PG8_SB(0, 0), cB, voffB); PG8_STAGE(PG8_SB(0, 1), cB + hstepB, voffB); PG8_STAGE(PG8_SA(0, 0), cA, voffA); PG8_STAGE(PG8_SA(0, 1), cA + hstepA, voffA);
        if (wr == 1) PG8_BAR;
        PG8_WAIT_V(2); PG8_BAR;
        PG8_STAGE(PG8_SB(1, 0), cB + kstep, voffB); PG8_STAGE(PG8_SA(1, 0), cA + kstep, voffA); PG8_STAGE(PG8_SB(1, 1), cB + hstepB + kstep, voffB);
        PG8_WAIT_V(6); PG8_BAR;
    } else {
        PG8_STAGE(PG8_SB(0, 0), cB, voffB); PG8_STAGE(PG8_SA(0, 0), cA, voffA); PG8_STAGE(PG8_SB(0, 1), cB + hstepB, voffB); PG8_STAGE(PG8_SA(0, 1), cA + hstepA, voffA);
        if (wr == 1) PG8_BAR;
        PG8_WAIT_V(4); PG8_BAR;
        PG8_STAGE(PG8_SB(1, 0), cB + kstep, voffB); PG8_STAGE(PG8_SA(1, 0), cA + kstep, voffA); PG8_STAGE(PG8_SB(1, 1), cB + hstepB + kstep, voffB);
        PG8_WAIT_V(6); PG8_BAR;
    }
    for (;;) {
        const bool has_next = S.next(ui + 1, nxt);
        const char* nA = has_next ? (const char*)g.A + (size_t)nxt.pm * tstepA + (size_t)nxt.ka * 2 : cA; const char* nB = has_next ? (const char*)g.Bt + (size_t)nxt.pn * tstepB + (size_t)nxt.ka * 2 : cB;
        for (int t = 0; t < nt; t += 2) {
            const bool last = (t == nt - 2);
            const char* a1 = cA + (size_t)(t + 1) * kstep;
            const char* a2 = last ? nA : cA + (size_t)(t + 2) * kstep; const char* b2 = last ? nB : cB + (size_t)(t + 2) * kstep;
            const char* a3 = a2 + kstep; const char* b3 = b2 + kstep;
            if (last && has_next) S.a_ready(nxt);
            if constexpr (SP2) {
            PG8_LDB(B0, 0, 0); PG8_LDB(B1, 0, 1); PG8_SCHED; PG8_LDA(At, 0, 0); PG8_STAGE(PG8_SA(1, 1), a1 + hstepA, voffA);
            PG8_WAIT_V(8); PG8_WAIT_L(0); PG8_BAR; PG8_MMA(0, 0, At, B0); PG8_MMA(0, 1, At, B1); PG8_BAR; PG8_SCHED;
            PG8_LDA(At, 0, 1); PG8_STAGE(PG8_SB(0, 0), b2, voffB); PG8_STAGE(PG8_SB(0, 1), b2 + hstepB, voffB); PG8_STAGE(PG8_SA(0, 0), a2, voffA);
            PG8_WAIT_V(8); PG8_WAIT_L(0); PG8_BAR; PG8_MMA(1, 0, At, B0); PG8_MMA(1, 1, At, B1); PG8_BAR; PG8_SCHED;
            PG8_LDB(B0, 1, 0); PG8_LDB(B1, 1, 1); PG8_SCHED; PG8_LDA(At, 1, 0); PG8_STAGE(PG8_SA(0, 1), a2 + hstepA, voffA);
            PG8_WAIT_V(8); PG8_WAIT_L(0); PG8_BAR; PG8_MMA(0, 0, At, B0); PG8_MMA(0, 1, At, B1); PG8_BAR; PG8_SCHED;
            PG8_LDA(At, 1, 1); PG8_STAGE(PG8_SB(1, 0), b3, voffB); PG8_STAGE(PG8_SB(1, 1), b3 + hstepB, voffB); PG8_STAGE(PG8_SA(1, 0), a3, voffA);
            PG8_WAIT_V(8); PG8_WAIT_L(0); PG8_BAR; PG8_MMA(1, 0, At, B0); PG8_MMA(1, 1, At, B1); PG8_BAR; PG8_SCHED;
            } else {
            PG8_LDB(B0, 0, 0); PG8_SCHED; PG8_LDA(At, 0, 0); PG8_STAGE(PG8_SA(1, 1), a1 + hstepA, voffA);
            PG8_WAIT_L(8); PG8_BAR; PG8_WAIT_L(0); PG8_MMA(0, 0, At, B0); PG8_BAR; PG8_SCHED;
            PG8_LDB(B1, 0, 1); PG8_STAGE(PG8_SB(0, 0), b2, voffB);
            PG8_BAR; PG8_WAIT_L(0); PG8_MMA(0, 1, At, B1); PG8_BAR;
            PG8_LDA(At, 0, 1); PG8_STAGE(PG8_SA(0, 0), a2, voffA);
            PG8_BAR; PG8_WAIT_L(0); PG8_MMA(1, 0, At, B0); PG8_BAR; PG8_SCHED;
            PG8_STAGE(PG8_SB(0, 1), b2 + hstepB, voffB);
            PG8_WAIT_V(6); PG8_BAR; PG8_MMA(1, 1, At, B1); PG8_BAR;
            PG8_LDB(B0, 1, 0); PG8_SCHED; PG8_LDA(At, 1, 0); PG8_STAGE(PG8_SA(0, 1), a2 + hstepA, voffA);
            PG8_WAIT_L(8); PG8_BAR; PG8_WAIT_L(0); PG8_MMA(0, 0, At, B0); PG8_BAR; PG8_SCHED;
            PG8_LDB(B1, 1, 1); PG8_STAGE(PG8_SB(1, 0), b3, voffB);
            PG8_BAR; PG8_WAIT_L(0); PG8_MMA(0, 1, At, B1); PG8_BAR;
            PG8_LDA(At, 1, 1); PG8_STAGE(PG8_SA(1, 0), a3, voffA);
            PG8_BAR; PG8_WAIT_L(0); PG8_MMA(1, 0, At, B0); PG8_BAR; PG8_SCHED;
            PG8_STAGE(PG8_SB(1, 1), b3 + hstepB, voffB);
            PG8_WAIT_V(6); PG8_BAR; PG8_MMA(1, 1, At, B1); PG8_BAR;
            }
        }
        if constexpr (ALIGN_EPI) { if (wr == 0) PG8_BAR; }
        if constexpr (!Epi::AFTER_DRAIN) { E(acc, cur, wr, wc, fr, fq); S.done(cur); }
        if (!has_next) break;
#pragma unroll
        for (int a = 0; a < 2; ++a)
#pragma unroll
            for (int b = 0; b < 2; ++b)
#pragma unroll
                for (int m = 0; m < 4; ++m)
#pragma unroll
                    for (int n = 0; n < 2; ++n) acc[a][b][m][n] = (f32x4){0.f, 0.f, 0.f, 0.f};
        cur = nxt; cA = nA; cB = nB; ++ui;
        if constexpr (ALIGN_EPI) { if (wr == 1) PG8_BAR; }
    }
    PG8_WAIT_V(0);
    if constexpr (!ALIGN_EPI) { if (wr == 0) PG8_BAR; }
    PG8_BAR;
    if constexpr (Epi::AFTER_DRAIN) { E.fused(acc, cur, wr, wc, fr, fq, lds, wid, lane); S.done(cur); }
#undef PG8_SA
#undef PG8_SB
#undef PG8_STAGE
#undef PG8_LDA
#undef PG8_LDB
#undef PG8_MMA
#undef PG8_WAIT_V
#undef PG8_WAIT_L
#undef PG8_BAR
#undef PG8_SCHED
}
}

__device__ __forceinline__ void p0_transpose_item(const float* W, int K, int N, bf16* WT, int row_off, float* scr, int item, int lane) {
    const int nblk = N / 32, kb = item / nblk, nb = item % nblk, k0 = 64 * kb, n0 = 32 * nb;
#pragma unroll 8
    for (int i = 0; i < 32; ++i) { const int kk = 2 * i + (lane >> 5); scr[kk * 33 + (lane & 31)] = W[(size_t)(k0 + kk) * N + n0 + (lane & 31)]; }
    asm volatile("s_waitcnt lgkmcnt(0)" ::: "memory");
    const int c = lane & 7;
#pragma unroll
    for (int j = 0; j < 4; ++j) { const int n = (lane >> 3) + 8 * j; const float* s = scr + (8 * c) * 33 + n;
        uint4 o; o.x = pk2(s[0 * 33], s[1 * 33]); o.y = pk2(s[2 * 33], s[3 * 33]); o.z = pk2(s[4 * 33], s[5 * 33]); o.w = pk2(s[6 * 33], s[7 * 33]);
        *(uint4*)(WT + (size_t)(row_off + n0 + n) * K + k0 + 8 * c) = o; }
    asm volatile("s_waitcnt lgkmcnt(0)" ::: "memory");
}
__device__ __forceinline__ void ph_convert(float* lds, const Args& a, bf16* Win_t, bf16* Wout_t, bf16* W13_t, bf16* W2_t, bf16* Wpool_t, bf16* Wr_t) {
    const int tid = tid_fresh(), lane = tid & 63, wave = tid >> 6;
    float* scr = lds + wave * (64 * 33);
    const int gw = blockIdx.x * 8 + wave, NGW = gridDim.x * 8;
    constexpr int I_IN = 16 * 80, I_OUT = 16 * 32, I_E13 = 16 * 8, I_E2 = 4 * 32, I_PL = 2 * 4;
    constexpr int NITEMS = I_IN + I_OUT + NE * 2 * I_E13 + NE * I_E2 + 4 * I_PL;
    for (int it = gw; it < NITEMS; it += NGW) {
        int r = it;
        if (r < I_IN) { p0_transpose_item((const float*)a.in[I_WIN], D, INC, Win_t, 0, scr, r, lane); continue; } r -= I_IN;
        if (r < I_OUT) { p0_transpose_item((const float*)a.in[I_WOUT], D, D, Wout_t, 0, scr, r, lane); continue; } r -= I_OUT;
        if (r < NE * 2 * I_E13) { const int e = r / (2 * I_E13), q = r % (2 * I_E13), is3 = q / I_E13, item = q % I_E13; const int h = (item % 8) / 4;
            const float* W = (const float*)a.in[is3 ? I_W3 : I_W1] + (size_t)e * D * DE;
            p0_transpose_item(W, D, DE, W13_t, e * 512 + h * 128 + is3 * 128, scr, item, lane); continue; } r -= NE * 2 * I_E13;
        if (r < NE * I_E2) { const int e = r / I_E2, item = r % I_E2; p0_transpose_item((const float*)a.in[I_W2] + (size_t)e * DE * D, DE, D, W2_t, e * 1024, scr, item, lane); continue; } r -= NE * I_E2;
        { const int g = r / I_PL, item = r % I_PL; p0_transpose_item((const float*)a.in[I_WPOOL] + (size_t)g * 128 * 128, 128, 128, Wpool_t, g * 128, scr, item, lane); }
    }
    { const float* wg = (const float*)a.in[I_WGRP]; const float* wr = (const float*)a.in[I_WRT];
      for (int it = blockIdx.x * NTHR + tid; it < 256 * 128; it += gridDim.x * NTHR) { const int j = it >> 7, k0 = (it & 127) * 8; float v[8];
#pragma unroll
          for (int q = 0; q < 8; ++q) v[q] = (j < 4) ? wg[(size_t)(k0 + q) * 4 + j] : (j < 36 ? wr[(size_t)(k0 + q) * 32 + (j - 4)] : 0.f);
          *(uint4*)(Wr_t + (size_t)j * D + k0) = make_uint4(pk2(v[0], v[1]), pk2(v[2], v[3]), pk2(v[4], v[5]), pk2(v[6], v[7])); } }
}

#define LAS __attribute__((address_space(3)))
#define XB_TMO      128
#define XB_XCNT(j)  (256  + 64 * (j))
#define XB_XSUB(j)  (1280 + 64 * (j))
#define XB_XGEN(j)  (2304 + 64 * (j))
#define XB_TOP      3328
#define XB_TOPGEN   3392
#define XCD_BAR_WORDS 3456
#define XB_SPIN_CAP (1u << 22)
__device__ __forceinline__ unsigned xb_ld(unsigned* p)              { return __hip_atomic_load(p, __ATOMIC_RELAXED, __HIP_MEMORY_SCOPE_AGENT); }
__device__ __forceinline__ unsigned xb_add(unsigned* p, unsigned v) { return __hip_atomic_fetch_add(p, v, __ATOMIC_RELAXED, __HIP_MEMORY_SCOPE_AGENT); }
__device__ __forceinline__ unsigned xb_xcc_id() { return (unsigned)__builtin_amdgcn_s_getreg((3 << 11) | 20) & 0xFu; }
#define XB_SPIN(cond, bar) do { unsigned _sp = 0; while (cond) { __builtin_amdgcn_s_sleep(1); \
    if ((++_sp & 255u) == 0u) { if (xb_ld(&(bar)[XB_TMO])) break; if (_sp > XB_SPIN_CAP) { atomicAdd(&(bar)[XB_TMO], 1u); break; } } } } while (0)
struct XcdBarrier { unsigned* bar; unsigned x; volatile LAS unsigned* st; };
__device__ __forceinline__ XcdBarrier xcd_barrier_post(unsigned* bar, volatile LAS unsigned* st) {
    XcdBarrier b; b.bar = bar; b.x = xb_xcc_id(); b.st = st;
    if (threadIdx.x == 0) (void)xb_add(&bar[XB_XCNT(b.x)], 1u);
    return b;
}
__device__ __forceinline__ void xcd_barrier_complete(unsigned* bar, unsigned x, unsigned& nloc, unsigned& nx) {
    const unsigned G = gridDim.x * gridDim.y * gridDim.z;
    unsigned sum, cnt, mine, sp = 0u;
    for (;;) {
        sum = 0u; cnt = 0u; mine = 0u;
#pragma unroll
        for (unsigned j = 0; j < 16; ++j) { const unsigned c = xb_ld(&bar[XB_XCNT(j)]); sum += c; cnt += (c > 0u) ? 1u : 0u; mine = (j == x) ? c : mine; }
        if (sum == G) break;
        __builtin_amdgcn_s_sleep(1);
        if ((++sp & 255u) == 0u) { if (xb_ld(&bar[XB_TMO])) break; if (sp > XB_SPIN_CAP) { atomicAdd(&bar[XB_TMO], 1u); break; } }
    }
    nloc = mine > 0u ? mine : 1u; nx = cnt > 0u ? cnt : 1u;
}
__device__ __forceinline__ void xcd_barrier(const XcdBarrier& b) {
    asm volatile("s_waitcnt vmcnt(0)" ::: "memory");
    __syncthreads();
    if (threadIdx.x == 0) {
        unsigned* bar = b.bar;
        __builtin_amdgcn_s_waitcnt(0);
        unsigned nloc = b.st[0], nx = b.st[1];
        if (nloc == 0u) { xcd_barrier_complete(bar, b.x, nloc, nx); b.st[0] = nloc; b.st[1] = nx; }
        const unsigned old = xb_add(&bar[XB_XSUB(b.x)], 1u);
        const unsigned gen = old / nloc;
        if (old + 1u == (gen + 1u) * nloc) {
            __builtin_amdgcn_fence(__ATOMIC_RELEASE, "agent");
            asm volatile("s_waitcnt vmcnt(0)" ::: "memory");
            const unsigned og = xb_add(&bar[XB_TOP], 1u);
            const unsigned tg = og / nx;
            if (og + 1u == (tg + 1u) * nx) xb_add(&bar[XB_TOPGEN], 1u);
            else XB_SPIN(xb_ld(&bar[XB_TOPGEN]) == tg, bar);
            __builtin_amdgcn_fence(__ATOMIC_ACQUIRE, "agent");
            xb_add(&bar[XB_XGEN(b.x)], 1u);
            asm volatile("s_waitcnt vmcnt(0)" ::: "memory");
        } else {
            XB_SPIN(xb_ld(&bar[XB_XGEN(b.x)]) == gen, bar);
            __builtin_amdgcn_fence(__ATOMIC_ACQUIRE, "agent");
            asm volatile("s_waitcnt vmcnt(0)" ::: "memory");
        }
    }
    __syncthreads();
}
constexpr int CW_BAR = 1024;


namespace rt {
typedef short bf16x8 __attribute__((ext_vector_type(8)));
typedef short s16x4 __attribute__((ext_vector_type(4)));
typedef float f32x16 __attribute__((ext_vector_type(16)));
typedef __bf16 bf16x2v __attribute__((ext_vector_type(2)));
typedef float f32x2v __attribute__((ext_vector_type(2)));
typedef unsigned u32x4 __attribute__((ext_vector_type(4)));
__device__ __forceinline__ void lds_st16(LAS unsigned char* p, unsigned x, unsigned y, unsigned z, unsigned w) { u32x4 v = {x, y, z, w}; *(LAS u32x4*)p = v; }
__device__ __forceinline__ u32x4 lds_ld16(const LAS unsigned char* p) { return *(const LAS u32x4*)p; }
#define RT_MFMA(a, b, c) __builtin_amdgcn_mfma_f32_32x32x16_bf16((a), (b), (c), 0, 0, 0)
__device__ __forceinline__ unsigned off_b(unsigned row, unsigned ch) { return 256u * row + 16u * (ch ^ (((row & 3u) << 2) | ((row >> 2) & 3u))); }
__device__ __forceinline__ unsigned cvt2(float lo, float hi) { f32x2v f = {lo, hi}; return __builtin_bit_cast(unsigned, __builtin_convertvector(f, bf16x2v)); }
__device__ __forceinline__ int crow(int reg, int h) { return (reg & 3) + 8 * (reg >> 2) + 4 * h; }
__device__ __forceinline__ bf16x8 row_frag(const LAS unsigned char* img, int rb, int s, int lane) { return *(const LAS bf16x8*)(img + off_b(32 * rb + (lane & 31), 2 * s + (lane >> 5))); }
__device__ __forceinline__ bf16x8 tr_frag(const LAS unsigned char* img, int cb, int r0, int r1, int lane) {
    const int blk = (lane >> 4) & 1, q = (lane & 15) >> 2, p = lane & 3; const unsigned ch = 4 * cb + 2 * blk + (p >> 1), sub = 8 * (p & 1);
    const s16x4 lo = __builtin_amdgcn_ds_read_tr16_b64_v4i16((LAS s16x4*)(img + off_b(r0 + q, ch) + sub));
    const s16x4 hi = __builtin_amdgcn_ds_read_tr16_b64_v4i16((LAS s16x4*)(img + off_b(r1 + q, ch) + sub));
    return __builtin_shufflevector(lo, hi, 0, 1, 2, 3, 4, 5, 6, 7);
}
__device__ __forceinline__ bf16x8 tr_frag_nat(const LAS unsigned char* img, int cb, int ks, int lane) { const int h = lane >> 5; return tr_frag(img, cb, 16 * ks + 8 * h, 16 * ks + 8 * h + 4, lane); }
__device__ __forceinline__ bf16x8 tr_frag_acc(const LAS unsigned char* img, int cb, int kb, int lane) { const int h = lane >> 5; return tr_frag(img, cb, kb + 4 * h, kb + 8 + 4 * h, lane); }
template <int S> __device__ __forceinline__ bf16x8 pack_acc(const f32x16& x) { u32x4 p; p.x = cvt2(x[8 * S], x[8 * S + 1]); p.y = cvt2(x[8 * S + 2], x[8 * S + 3]); p.z = cvt2(x[8 * S + 4], x[8 * S + 5]); p.w = cvt2(x[8 * S + 6], x[8 * S + 7]); return __builtin_bit_cast(bf16x8, p); }

__device__ __forceinline__ void stage_rot_tile(LAS unsigned char* img, const bf16* src  , const float2* rot  , float scale, bool kdec, float log2g, int tid) {
#pragma unroll
    for (int i = 0; i < 2; ++i) { const int it = tid + NTHR * i, r = it >> 3, c8 = it & 7;
        const uint4 lo = *(const uint4*)(src + (size_t)r * INC + 8 * c8), hi = *(const uint4*)(src + (size_t)r * INC + 64 + 8 * c8);
        const float4* cs = (const float4*)(rot + (size_t)r * 64 + 8 * c8);
        const float f = kdec ? scale * exp2f((float)(127 - r) * log2g) : scale;
        const unsigned lw[4] = {lo.x, lo.y, lo.z, lo.w}, hw[4] = {hi.x, hi.y, hi.z, hi.w}; unsigned o1[4], o2[4];
#pragma unroll
        for (int w = 0; w < 4; ++w) { const float4 c = cs[w];
            const float a0 = bflo(lw[w]), a1 = bfhi(lw[w]), b0 = bflo(hw[w]), b1 = bfhi(hw[w]);
            o1[w] = cvt2((a0 * c.x - b0 * c.y) * f, (a1 * c.z - b1 * c.w) * f); o2[w] = cvt2((a0 * c.y + b0 * c.x) * f, (a1 * c.w + b1 * c.z) * f); }
        lds_st16(img + off_b(r, c8), o1[0], o1[1], o1[2], o1[3]); lds_st16(img + off_b(r, c8 + 8), o2[0], o2[1], o2[2], o2[3]); }
}
__device__ __forceinline__ void stage_copy_tile(LAS unsigned char* img, const bf16* src, int ld, int tid) {
#pragma unroll
    for (int i = 0; i < 4; ++i) { const int it = tid + NTHR * i, r = it >> 4, ch = it & 15; const uint4 v = *(const uint4*)(src + (size_t)r * ld + 8 * ch); lds_st16(img + off_b(r, ch), v.x, v.y, v.z, v.w); }
}
__device__ __forceinline__ void stage_f32_tile(LAS unsigned char* img, const float* src, int tid) {
#pragma unroll
    for (int i = 0; i < 4; ++i) { const int it = tid + NTHR * i, r = it >> 4, ch = it & 15; const float4 a = *(const float4*)(src + r * 128 + 8 * ch), b = *(const float4*)(src + r * 128 + 8 * ch + 4);
        lds_st16(img + off_b(r, ch), cvt2(a.x, a.y), cvt2(a.z, a.w), cvt2(b.x, b.y), cvt2(b.z, b.w)); }
}

__device__ __forceinline__ void ph_kv(LAS unsigned char* lds, const bf16* proj, const float2* rot, float* KV) {
    const int tid = tid_fresh(), lane = tid & 63, wave = tid >> 6, eb = wave >> 1, dh = wave & 1, hl = lane >> 5;
    LAS unsigned char* Kimg = lds; LAS unsigned char* Vimg = lds + 32768;
    for (int unit = blockIdx.x; unit < 512; unit += gridDim.x) {
        const int h = unit & 3, bn = unit >> 2; const size_t row0 = (size_t)bn * 128;
        const float log2g = log2f(1.0f - exp2f(-5.0f - (float)h));
        __syncthreads();
        stage_rot_tile(Kimg, proj + row0 * INC + 512 + h * 128, rot + row0 * 64, 0.08838834764831845f, true, log2g, tid);
        stage_copy_tile(Vimg, proj + row0 * INC + 1024 + h * 128, INC, tid);
        __syncthreads();
        f32x16 acc[2];
#pragma unroll
        for (int j = 0; j < 2; ++j)
#pragma unroll
            for (int q = 0; q < 16; ++q) acc[j][q] = 0.f;
#pragma unroll
        for (int ks = 0; ks < 8; ++ks) { const bf16x8 a = tr_frag_nat(Vimg, eb, ks, lane);
#pragma unroll
            for (int j = 0; j < 2; ++j) { const bf16x8 bq = tr_frag_nat(Kimg, 2 * dh + j, ks, lane); acc[j] = RT_MFMA(a, bq, acc[j]); } }
        float* out = KV + (size_t)unit * 16384;
#pragma unroll
        for (int j = 0; j < 2; ++j)
#pragma unroll
            for (int q = 0; q < 16; ++q) out[(32 * eb + crow(q, hl)) * 128 + 32 * (2 * dh + j) + (lane & 31)] = acc[j][q];
    }
}
__device__ __forceinline__ void ph_scan(float* KV) {
    for (int it = blockIdx.x * NTHR + tid_fresh(); it < 32 * 4096; it += gridDim.x * NTHR) {
        const int bh = it >> 12, idx = it & 4095, b = bh >> 2, h = bh & 3;
        const float cd = exp2f(128.0f * log2f(1.0f - exp2f(-5.0f - (float)h)));
        float4* p = (float4*)KV + ((size_t)(b * 16) * 4 + h) * 4096 + idx;
        float4 v[16];
#pragma unroll
        for (int n = 0; n < 16; ++n) v[n] = p[(size_t)n * 4 * 4096];
        float4 st = make_float4(0.f, 0.f, 0.f, 0.f);
#pragma unroll
        for (int n = 0; n < 16; ++n) { p[(size_t)n * 4 * 4096] = st; st.x = st.x * cd + v[n].x; st.y = st.y * cd + v[n].y; st.z = st.z * cd + v[n].z; st.w = st.w * cd + v[n].w; }
    }
}
__device__ __forceinline__ void ph_retention(LAS unsigned char* lds, const bf16* proj, const float2* rot, const float* KV, const float* gnw, bf16* mix) {
    const int tid = tid_fresh(), lane = tid & 63, wave = tid >> 6, ib = wave >> 1, eh = wave & 1, hl = lane >> 5, il = lane & 31;
    LAS unsigned char* Qimg = lds; LAS unsigned char* Kimg = lds + 32768; LAS unsigned char* Vimg = lds + 65536; LAS unsigned char* Simg = lds + 98304;
    LAS float* red = (LAS float*)(lds + 131072);
    for (int unit = blockIdx.x; unit < 512; unit += gridDim.x) {
        const int h = unit & 3, bn = unit >> 2, n = bn & 15; const size_t row0 = (size_t)bn * 128;
        const float log2g = log2f(1.0f - exp2f(-5.0f - (float)h));
        __syncthreads();
        stage_rot_tile(Qimg, proj + row0 * INC + h * 128, rot + row0 * 64, 1.0f, false, 0.f, tid);
        stage_rot_tile(Kimg, proj + row0 * INC + 512 + h * 128, rot + row0 * 64, 1.0f, false, 0.f, tid);
        stage_copy_tile(Vimg, proj + row0 * INC + 1024 + h * 128, INC, tid);
        if (n > 0) stage_f32_tile(Simg, KV + (size_t)unit * 16384, tid);
        __syncthreads();
        bf16x8 qf[8];
#pragma unroll
        for (int s = 0; s < 8; ++s) qf[s] = row_frag(Qimg, ib, s, lane);
        f32x16 acc[2];
#pragma unroll
        for (int j = 0; j < 2; ++j)
#pragma unroll
            for (int q = 0; q < 16; ++q) acc[j][q] = 0.f;
        if (n > 0) {
#pragma unroll
            for (int s = 0; s < 8; ++s)
#pragma unroll
                for (int j = 0; j < 2; ++j) acc[j] = RT_MFMA(row_frag(Simg, 2 * eh + j, s, lane), qf[s], acc[j]);
            const float qd = exp2f((float)(32 * ib + il + 1) * log2g);
#pragma unroll
            for (int j = 0; j < 2; ++j)
#pragma unroll
                for (int q = 0; q < 16; ++q) acc[j][q] *= qd;
        }
        for (int mb = 0; mb <= ib; ++mb) {
            f32x16 sc;
#pragma unroll
            for (int q = 0; q < 16; ++q) sc[q] = 0.f;
#pragma unroll
            for (int s = 0; s < 8; ++s) sc = RT_MFMA(row_frag(Kimg, mb, s, lane), qf[s], sc);
            const int i = 32 * ib + il;
#pragma unroll
            for (int q = 0; q < 16; ++q) { const int m = 32 * mb + crow(q, hl); const float f = (i >= m) ? 0.08838834764831845f * exp2f((float)(i - m) * log2g) : 0.f; sc[q] *= f; }
            const bf16x8 p0 = pack_acc<0>(sc), p1 = pack_acc<1>(sc);
#pragma unroll
            for (int j = 0; j < 2; ++j) { acc[j] = RT_MFMA(tr_frag_acc(Vimg, 2 * eh + j, 32 * mb, lane), p0, acc[j]); acc[j] = RT_MFMA(tr_frag_acc(Vimg, 2 * eh + j, 32 * mb + 16, lane), p1, acc[j]); }
        }
        float s1 = 0.f, s2 = 0.f;
#pragma unroll
        for (int j = 0; j < 2; ++j)
#pragma unroll
            for (int q = 0; q < 16; ++q) { s1 += acc[j][q]; s2 += acc[j][q] * acc[j][q]; }
        s1 += __shfl_xor(s1, 32); s2 += __shfl_xor(s2, 32);
        if (hl == 0) { red[(wave * 32 + il) * 2] = s1; red[(wave * 32 + il) * 2 + 1] = s2; }
        __syncthreads();
        { const int ow = wave ^ 1; s1 += red[(ow * 32 + il) * 2]; s2 += red[(ow * 32 + il) * 2 + 1]; }
        const float mean = s1 * (1.f / 128.f), var = fmaxf(s2 * (1.f / 128.f) - mean * mean, 0.f), rstd = 1.f / sqrtf(var + LN_EPS);
        const size_t row = row0 + 32 * ib + il;
#pragma unroll
        for (int j = 0; j < 2; ++j)
#pragma unroll
            for (int g = 0; g < 4; ++g) { const int e0 = 32 * (2 * eh + j) + 8 * g + 4 * hl;
                const uint2 gr = *(const uint2*)(proj + row * INC + 1536 + h * 128 + e0); const float4 gw = *(const float4*)(gnw + h * 128 + e0);
                const float g0 = bflo(gr.x), g1 = bfhi(gr.x), g2 = bflo(gr.y), g3 = bfhi(gr.y);
                const float o0 = silu_f(g0) * ((acc[j][4 * g] - mean) * rstd * gw.x), o1 = silu_f(g1) * ((acc[j][4 * g + 1] - mean) * rstd * gw.y);
                const float o2 = silu_f(g2) * ((acc[j][4 * g + 2] - mean) * rstd * gw.z), o3 = silu_f(g3) * ((acc[j][4 * g + 3] - mean) * rstd * gw.w);
                *(uint2*)(mix + row * D + h * 128 + e0) = make_uint2(cvt2(o0, o1), cvt2(o2, o3)); }
    }
}
__device__ __forceinline__ void ph_pool(LAS unsigned char* lds, const bf16* proj, const bf16* Wpool_t, const float* pscale, bf16* mix) {
    const int tid = tid_fresh(), lane = tid & 63, wave = tid >> 6, tb = wave >> 1, dh = wave & 1, hl = lane >> 5, il = lane & 31;
    LAS unsigned char* Pin = lds;
    LAS unsigned char* Pimg = lds + 36864; LAS unsigned char* Wimg = lds + 36864 + 32768;
    for (int unit = blockIdx.x; unit < 512; unit += gridDim.x) {
        const int g = unit & 3, rb = unit >> 2, win = 2 << g; const int row0 = rb * 128, s0 = row0 & (SEQ - 1);
        __syncthreads();
        for (int it = tid; it < 143 * 16; it += NTHR) { const int pr = it >> 4, ch = it & 15; const int s = s0 + pr - 15;
            uint4 v = make_uint4(0u, 0u, 0u, 0u); if (s >= 0) v = *(const uint4*)(proj + (size_t)(row0 + pr - 15) * INC + 2048 + g * 128 + 8 * ch);
            lds_st16(Pin + pr * 256 + ch * 16, v.x, v.y, v.z, v.w); }
        stage_copy_tile(Wimg, Wpool_t + (size_t)g * 128 * 128, 128, tid);
        __syncthreads();
#pragma unroll
        for (int i = 0; i < 4; ++i) { const int it = tid + NTHR * i, r = it >> 4, ch = it & 15; const int s = s0 + r; const int cnt = (s + 1 < win) ? (s + 1) : win;
            float sum[8] = {0.f, 0.f, 0.f, 0.f, 0.f, 0.f, 0.f, 0.f};
            for (int j = 0; j < cnt; ++j) { const u32x4 v = lds_ld16(Pin + (r + 15 - j) * 256 + ch * 16);
                sum[0] += bflo(v.x); sum[1] += bfhi(v.x); sum[2] += bflo(v.y); sum[3] += bfhi(v.y); sum[4] += bflo(v.z); sum[5] += bfhi(v.z); sum[6] += bflo(v.w); sum[7] += bfhi(v.w); }
            const u32x4 me = lds_ld16(Pin + (r + 15) * 256 + ch * 16); const float ic = 1.0f / (float)cnt;
            lds_st16(Pimg + off_b(r, ch), cvt2(sum[0] * ic - bflo(me.x), sum[1] * ic - bfhi(me.x)), cvt2(sum[2] * ic - bflo(me.y), sum[3] * ic - bfhi(me.y)),
                                                            cvt2(sum[4] * ic - bflo(me.z), sum[5] * ic - bfhi(me.z)), cvt2(sum[6] * ic - bflo(me.w), sum[7] * ic - bfhi(me.w))); }
        __syncthreads();
        f32x16 acc[2];
#pragma unroll
        for (int j = 0; j < 2; ++j)
#pragma unroll
            for (int q = 0; q < 16; ++q) acc[j][q] = 0.f;
#pragma unroll
        for (int s = 0; s < 8; ++s) { const bf16x8 bq = row_frag(Pimg, tb, s, lane);
#pragma unroll
            for (int j = 0; j < 2; ++j) acc[j] = RT_MFMA(row_frag(Wimg, 2 * dh + j, s, lane), bq, acc[j]); }
        const size_t row = (size_t)row0 + 32 * tb + il;
#pragma unroll
        for (int j = 0; j < 2; ++j)
#pragma unroll
            for (int q = 0; q < 4; ++q) { const int d0 = 32 * (2 * dh + j) + 8 * q + 4 * hl; const float4 ps = *(const float4*)(pscale + g * 128 + d0);
                *(uint2*)(mix + row * D + 512 + g * 128 + d0) = make_uint2(cvt2(acc[j][4 * q] * ps.x, acc[j][4 * q + 1] * ps.y), cvt2(acc[j][4 * q + 2] * ps.z, acc[j][4 * q + 3] * ps.w)); }
    }
}
#undef RT_MFMA
}


__device__ __forceinline__ void ph_ln_route(LAS unsigned char* lds, float* V1, const float* ln1w, const float* ln1b, const float* ada, bf16* U2, const bf16* Wr_t, const float* bg, const float* br,
                                            int* tok_e, float* tok_w, int* hist) {
    using namespace rt;
    const int tid = tid_fresh(), lane = tid & 63, wave = tid >> 6, hh = lane >> 5, il = lane & 31;
    constexpr int RS = 2064;
    LAS unsigned char* img = lds;
    LAS float* red = (LAS float*)(lds + 66048);
    LAS int* hs = (LAS int*)(lds + 66048 + 65536);
    bf16x8 bfr[8][2];
#pragma unroll
    for (int s = 0; s < 8; ++s)
#pragma unroll
        for (int cb = 0; cb < 2; ++cb) bfr[s][cb] = *(const bf16x8*)(Wr_t + (size_t)(32 * cb + il) * D + 16 * (8 * wave + s) + 8 * hh);
    for (int blk = blockIdx.x; blk < T / 64; blk += gridDim.x) {
        __syncthreads();
        if (tid < 32) hs[tid] = 0;
        const int b = (blk * 64) / SEQ;
        for (int pass = 0; pass < 2; ++pass) {
            const int rbase = blk * 64 + pass * 32;
            for (int i = 0; i < 4; ++i) {
                const int rl = wave * 4 + i, row = rbase + rl;
                float4* xr = (float4*)(V1 + (size_t)row * D) + lane;
                float4 v[4]; float s = 0.f;
#pragma unroll
                for (int j = 0; j < 4; ++j) { v[j] = xr[64 * j]; s += (v[j].x + v[j].y) + (v[j].z + v[j].w); }
                float mean = wave_sum(s) * (1.f / D); float s2 = 0.f;
#pragma unroll
                for (int j = 0; j < 4; ++j) { v[j].x -= mean; v[j].y -= mean; v[j].z -= mean; v[j].w -= mean; s2 += (v[j].x * v[j].x + v[j].y * v[j].y) + (v[j].z * v[j].z + v[j].w * v[j].w); }
                float rstd = 1.f / sqrtf(wave_sum(s2) * (1.f / D) + LN_EPS);
                s = 0.f;
#pragma unroll
                for (int j = 0; j < 4; ++j) { const float4 lw = *((const float4*)ln1w + lane + 64 * j), lb = *((const float4*)ln1b + lane + 64 * j);
                    v[j].x = v[j].x * rstd * lw.x + lb.x; v[j].y = v[j].y * rstd * lw.y + lb.y; v[j].z = v[j].z * rstd * lw.z + lb.z; v[j].w = v[j].w * rstd * lw.w + lb.w;
                    xr[64 * j] = v[j]; s += (v[j].x + v[j].y) + (v[j].z + v[j].w); }
                mean = wave_sum(s) * (1.f / D); s2 = 0.f;
#pragma unroll
                for (int j = 0; j < 4; ++j) { v[j].x -= mean; v[j].y -= mean; v[j].z -= mean; v[j].w -= mean; s2 += (v[j].x * v[j].x + v[j].y * v[j].y) + (v[j].z * v[j].z + v[j].w * v[j].w); }
                rstd = 1.f / sqrtf(wave_sum(s2) * (1.f / D) + LN_EPS);
                const float* sh2 = ada + (size_t)b * ADA + 3 * D; const float* sc2 = ada + (size_t)b * ADA + 4 * D;
                uint2* o = (uint2*)(U2 + (size_t)row * D) + lane;
#pragma unroll
                for (int j = 0; j < 4; ++j) { const float4 sc = *((const float4*)sc2 + lane + 64 * j), sh = *((const float4*)sh2 + lane + 64 * j);
                    const unsigned p0 = cvt2(v[j].x * rstd * (1.f + sc.x) + sh.x, v[j].y * rstd * (1.f + sc.y) + sh.y), p1 = cvt2(v[j].z * rstd * (1.f + sc.z) + sh.z, v[j].w * rstd * (1.f + sc.w) + sh.w);
                    o[64 * j] = make_uint2(p0, p1);
                    typedef unsigned u32x2 __attribute__((ext_vector_type(2))); u32x2 pv = {p0, p1}; *(LAS u32x2*)(img + rl * RS + (4 * lane + 256 * j) * 2) = pv; }
            }
            __syncthreads();
            f32x16 acc[2];
#pragma unroll
            for (int cb = 0; cb < 2; ++cb)
#pragma unroll
                for (int q = 0; q < 16; ++q) acc[cb][q] = 0.f;
#pragma unroll
            for (int s = 0; s < 8; ++s) { const bf16x8 a = *(const LAS bf16x8*)(img + il * RS + (16 * (8 * wave + s) + 8 * hh) * 2);
                acc[0] = __builtin_amdgcn_mfma_f32_32x32x16_bf16(a, bfr[s][0], acc[0], 0, 0, 0); acc[1] = __builtin_amdgcn_mfma_f32_32x32x16_bf16(a, bfr[s][1], acc[1], 0, 0, 0); }
#pragma unroll
            for (int cb = 0; cb < 2; ++cb)
#pragma unroll
                for (int q = 0; q < 16; ++q) red[(wave * 32 + crow(q, hh)) * 64 + 32 * cb + il] = acc[cb][q];
            __syncthreads();
#pragma unroll
            for (int i = 0; i < 4; ++i) { const int idx = tid + NTHR * i; float s = red[idx];
#pragma unroll
                for (int w = 1; w < 8; ++w) s += red[w * 2048 + idx];
                red[idx] = s; }
            __syncthreads();
            if (tid < 32) {
                const int t = rbase + tid; const LAS float* lg = red + tid * 64;
                float gl[4];
#pragma unroll
                for (int j = 0; j < 4; ++j) gl[j] = lg[j] + bg[j];
                int gi = 0; float gm = gl[0];
#pragma unroll
                for (int j = 1; j < 4; ++j) if (gl[j] > gm) { gm = gl[j]; gi = j; }
                float den = 0.f;
#pragma unroll
                for (int j = 0; j < 4; ++j) den += expf(gl[j] - gm);
                const float gprob = 1.0f / den;
                float el[8];
#pragma unroll
                for (int i = 0; i < 8; ++i) el[i] = lg[4 + gi * 8 + i] + br[gi * 8 + i];
                int i0 = 0; float v0 = el[0];
#pragma unroll
                for (int i = 1; i < 8; ++i) if (el[i] > v0) { v0 = el[i]; i0 = i; }
                int i1 = -1; float v1 = 0.f;
#pragma unroll
                for (int i = 0; i < 8; ++i) if (i != i0 && (i1 < 0 || el[i] > v1)) { v1 = el[i]; i1 = i; }
                const float ex = expf(v1 - v0), inv = 1.0f / (1.0f + ex);
                tok_e[2 * t] = gi * 8 + i0; tok_e[2 * t + 1] = gi * 8 + i1;
                tok_w[2 * t] = gprob * inv; tok_w[2 * t + 1] = gprob * ex * inv;
                atomicAdd((int*)&hs[gi * 8 + i0], 1); atomicAdd((int*)&hs[gi * 8 + i1], 1);
            }
            __syncthreads();
        }
        if (tid < 32) hist[blk * 32 + tid] = hs[tid];
    }
}

constexpr int LDS_BYTES = 147456;
constexpr int MISC_OFF = LDS_BYTES - 64;
constexpr int N_PHASES = 13;

__global__ void __launch_bounds__(NTHR, 2) mk_fwd(Args args) {
    extern __shared__ __attribute__((aligned(16))) unsigned char lds_raw[];
    float* lds = (float*)lds_raw;
    unsigned char* ws = args.ws;
    const float* x = (const float*)args.in[I_X];
    float* part = (float*)(ws + WS_ADAP); float* ada = (float*)(ws + WS_ADA);
    int* tok_e = (int*)(ws + WS_TOKE); float* tok_w = (float*)(ws + WS_TOKW);
    float2* rot = (float2*)(ws + WS_ROT);
    bf16* U = (bf16*)(ws + WS_U); bf16* PROJ = (bf16*)(ws + WS_PROJ); float* V1 = (float*)(ws + WS_V1);
    float* LOG = (float*)(ws + WS_LOG); bf16* MIX = (bf16*)(ws + WS_MIX); float* Y2 = (float*)(ws + WS_Y2);
    volatile LAS unsigned* MISC = (volatile LAS unsigned*)((LAS unsigned char*)lds_raw + MISC_OFF);
    if (threadIdx.x < 16) MISC[threadIdx.x] = 0u;
    __syncthreads();
    XcdBarrier bar = xcd_barrier_post((unsigned*)(ws + WS_CTL) + CW_BAR, MISC);
    LAS unsigned char* ldsl = (LAS unsigned char*)lds_raw;
    float* KV = (float*)(ws + WS_KV);
#define GRID_BAR() xcd_barrier(bar)
    ph_ada_partial(lds, (const float*)args.in[I_C], (const float*)args.in[I_WADA], part); __syncthreads(); ph_rot_table((const int*)args.in[I_POS], rot);
    ph_convert(lds, args, (bf16*)(ws + WS_WIN), (bf16*)(ws + WS_WOUT), (bf16*)(ws + WS_W13), (bf16*)(ws + WS_W2), (bf16*)(ws + WS_WPOOL), (bf16*)(ws + WS_WR));
    GRID_BAR();
    ph_ada_final_lnmod(lds, x, part, (const float*)args.in[I_BADA], ada, U);
    GRID_BAR();
    { pg8::Gemm g{U, (const bf16*)(ws + WS_WIN), T, INC, D, D, D}; pg8::StaticOrder S; S.init(T, INC, (int)gridDim.x, (int)blockIdx.x);
      pg8::EpiBf16<0> E{PROJ, INC, nullptr, 0, 0, 1.f};
      pg8::gemm_phase<pg8::EpiBf16<0>, pg8::StaticOrder, true, true>(ldsl, g, S, E); }
    GRID_BAR();
#if USE_NAIVE_RET
    ph_ret_naive(lds, PROJ, rot, (const float*)args.in[I_GNW], MIX);
#else
    rt::ph_kv(ldsl, PROJ, rot, KV);
    GRID_BAR();
    rt::ph_scan(KV);
#endif
#if USE_NAIVE_POOL
    ph_pool_naive(lds, PROJ, (const float*)args.in[I_WPOOL], (const float*)args.in[I_PSCALE], MIX);
#else
    __syncthreads();
    rt::ph_pool(ldsl, PROJ, (const bf16*)(ws + WS_WPOOL), (const float*)args.in[I_PSCALE], MIX);
#endif
#if !USE_NAIVE_RET
    GRID_BAR();
    rt::ph_retention(ldsl, PROJ, rot, KV, (const float*)args.in[I_GNW], MIX);
#endif
    GRID_BAR();
    { pg8::Gemm g{MIX, (const bf16*)(ws + WS_WOUT), T, D, D, D, D}; pg8::StaticOrder S; S.init(T, D, (int)gridDim.x, (int)blockIdx.x);
      pg8::EpiV1f E{x, ada, V1};
      pg8::gemm_phase<pg8::EpiV1f, pg8::StaticOrder, true, true>(ldsl, g, S, E); }
    GRID_BAR();
    ph_ln_route(ldsl, V1, (const float*)args.in[I_LN1W], (const float*)args.in[I_LN1B], ada, U, (const bf16*)(ws + WS_WR), (const float*)args.in[I_BGRP], (const float*)args.in[I_BRT], tok_e, tok_w, (int*)(ws + WS_HIST));
    GRID_BAR();
    ph_permute(lds, (const int*)(ws + WS_HIST), tok_e, tok_w, U, (int*)(ws + WS_TOKS), (float*)(ws + WS_SLOTW), (int*)(ws + WS_TILEE), (bf16*)(ws + WS_U2S));
    GRID_BAR();
    { pg8::Gemm g{(const bf16*)(ws + WS_U2S), (const bf16*)(ws + WS_W13), MAXSLOT, NE * 512, D, D, D}; pg8::MoeOrder<2> S; S.init((const int*)(ws + WS_TILEE), (int)gridDim.x, (int)blockIdx.x);
      pg8::EpiMoeUp E{(bf16*)(ws + WS_HS), (const float*)(ws + WS_SLOTW)};
      pg8::gemm_phase<pg8::EpiMoeUp, pg8::MoeOrder<2>, true, true>(ldsl, g, S, E); }
    GRID_BAR();
    { pg8::Gemm g{(const bf16*)(ws + WS_HS), (const bf16*)(ws + WS_W2), MAXSLOT, NE * D, DE, DE, DE}; pg8::MoeOrder<4> S; S.init((const int*)(ws + WS_TILEE), (int)gridDim.x, (int)blockIdx.x);
      pg8::EpiBf16<0> E{(bf16*)(ws + WS_YS), D, nullptr, D, 0, 1.f};
      pg8::gemm_phase<pg8::EpiBf16<0>, pg8::MoeOrder<4>, false, true>(ldsl, g, S, E); }
    GRID_BAR();
    ph_final_slots(V1, (const bf16*)(ws + WS_YS), (const int*)(ws + WS_TOKS), ada, (const float*)args.in[I_LN2W], (const float*)args.in[I_LN2B], args.out);
#undef GRID_BAR
}

extern "C" void kernel_launch(void* const* d_in, const int* in_sizes, int n_in, void* d_out, int out_size, void* d_ws, size_t ws_size, hipStream_t stream) {
    static int grid = 0;
    if (grid == 0) {
        if (n_in != 21 || in_sizes[0] != T * D || out_size != T * D || ws_size < WS_END) { fprintf(stderr, "kernel_launch: unexpected shapes (n_in %d, in0 %d, out %d, ws %zu)\n", n_in, n_in > 0 ? in_sizes[0] : -1, out_size, ws_size); grid = -1; return; }
        if (hipFuncSetAttribute((const void*)mk_fwd, hipFuncAttributeMaxDynamicSharedMemorySize, LDS_BYTES) != hipSuccess) { fprintf(stderr, "kernel_launch: hipFuncSetAttribute failed\n"); grid = -1; return; }
        int dev = 0, cus = 0, per_cu = 0;
        if (hipGetDevice(&dev) != hipSuccess || hipDeviceGetAttribute(&cus, hipDeviceAttributeMultiprocessorCount, dev) != hipSuccess) { grid = -1; return; }
        if (hipOccupancyMaxActiveBlocksPerMultiprocessor(&per_cu, (const void*)mk_fwd, NTHR, LDS_BYTES) != hipSuccess || per_cu < 1) { fprintf(stderr, "kernel_launch: occupancy query says %d blocks per CU\n", per_cu); (void)hipGetLastError(); per_cu = 1; }
        grid = cus;
        if (grid > NWG) grid = NWG;
    }
    if (grid < 0) return;
    Args a{};
    for (int i = 0; i < 21; ++i) a.in[i] = d_in[i];
    a.out = (float*)d_out; a.ws = (unsigned char*)d_ws;
    if (hipMemsetAsync((char*)d_ws + WS_CTL, 0, CTL_ZERO_BYTES, stream) != hipSuccess) { fprintf(stderr, "kernel_launch: hipMemsetAsync failed\n"); return; }
    a.ph_lo = 0; a.ph_hi = N_PHASES; a.li = 0;
    hipLaunchKernelGGL(mk_fwd, dim3(grid), dim3(NTHR), LDS_BYTES, stream, a);
}
```
